# Optimizing an MI355X kernel written in HIP

```python
import jax
import jax.numpy as jnp
from jax import lax
import numpy as np


D_MODEL = 2048
BATCH = 1
SEQ = 8192
DEPTH = 4

ROPE_THETA = 10000.0
ROPE_DIM = 64
NORM_EPS = 1e-5

SSM_HEADS = 32
SSM_HEAD_DIM = 64
SSM_INNER = SSM_HEADS * SSM_HEAD_DIM
SSM_GROUPS = 4
SSM_HEADS_PER_GROUP = SSM_HEADS // SSM_GROUPS
SSM_STATE = 128
SSM_CONV = 4
SSM_CHUNK = 128
SSM_CONV_DIM = SSM_INNER + 2 * SSM_GROUPS * SSM_STATE

SWA_Q_HEADS = 16
SWA_KV_HEADS = 2
SWA_HEAD_DIM = ROPE_DIM
SWA_WINDOW = 128
ATTN_BLOCK = 128

EVEN_IN = SSM_INNER + SSM_CONV_DIM + SSM_HEADS + (SWA_Q_HEADS + 2 * SWA_KV_HEADS) * SWA_HEAD_DIM
EVEN_MIX = SSM_INNER + SWA_Q_HEADS * SWA_HEAD_DIM

MLA_HEADS = 16
MLA_NOPE = 128
MLA_ROPE = ROPE_DIM
MLA_V = 128
MLA_RANK = 512
MLA_SCALE = (MLA_NOPE + MLA_ROPE) ** -0.5
IDX_HEADS = 16
IDX_DIM = ROPE_DIM
IDX_TOPK_MAX = 256
ODD_IN = MLA_HEADS * (MLA_NOPE + MLA_ROPE) + MLA_RANK + MLA_ROPE + IDX_HEADS * IDX_DIM + IDX_DIM + IDX_HEADS
ODD_MIX = MLA_HEADS * MLA_V

MOE_GROUPS = 4
MOE_EXPERTS_PER_GROUP = 8
MOE_EXPERTS = MOE_GROUPS * MOE_EXPERTS_PER_GROUP
MOE_TOP_K = 2
MOE_FF = 512
MOE_BLOCK = 128

PLE_DIM = 256

DEEPNORM_ALPHA = (2 * DEPTH) ** 0.25
DEEPNORM_BETA = (8 * DEPTH) ** -0.25
N_EVEN = (DEPTH + 1) // 2
N_ODD = DEPTH // 2

kernel_name = 'hybrid_ssd_swa_dsa_hmoe_deepnorm'

F32 = jnp.float32


def _split(a, sizes):
    return jnp.split(a, [int(v) for v in np.cumsum(sizes)[:-1]], axis=-1)


def layer_norm(x, g, b):
    xf = x.astype(F32)
    xc = xf - xf.mean(-1, keepdims=True)
    var = jnp.mean(xc * xc, -1, keepdims=True)
    return (xc * lax.rsqrt(var + NORM_EPS) * g.astype(F32) + b.astype(F32)).astype(x.dtype)


def rms_norm(x, g):
    xf = x.astype(F32)
    return (xf * lax.rsqrt(jnp.mean(xf * xf, -1, keepdims=True) + NORM_EPS) * g.astype(F32)).astype(x.dtype)


def rope_tables(positions):
    inv = ROPE_THETA ** (-jnp.arange(0, ROPE_DIM, 2, dtype=F32) / ROPE_DIM)
    ang = positions.astype(F32)[..., None] * inv
    return jnp.cos(ang), jnp.sin(ang)


def apply_rope(t, cos, sin):
    tf = t.astype(F32)
    t1, t2 = jnp.split(tf, 2, axis=-1)
    c = cos[:, :, None, :]
    s_ = sin[:, :, None, :]
    return jnp.concatenate([t1 * c - t2 * s_, t2 * c + t1 * s_], axis=-1).astype(t.dtype)


def causal_dwconv(u, w, bias):
    c = u.shape[-1]
    out = lax.conv_general_dilated(u, w[:, None, :].astype(u.dtype), window_strides=(1,),
                                   padding=[(SSM_CONV - 1, 0)],
                                   dimension_numbers=('NWC', 'WIO', 'NWC'),
                                   feature_group_count=c)
    return out + bias.astype(u.dtype)


def ssd_chunked(xdt, a, bm, cm):
    b, s, g, r, p = xdt.shape
    n = bm.shape[-1]
    nc = s // SSM_CHUNK
    X = xdt.reshape(b, nc, SSM_CHUNK, g, r, p)
    A = a.reshape(b, nc, SSM_CHUNK, g, r)
    B = bm.reshape(b, nc, SSM_CHUNK, g, n)
    C = cm.reshape(b, nc, SSM_CHUNK, g, n)
    a_cs = jnp.cumsum(A, axis=2)
    seg = a_cs[:, :, :, None] - a_cs[:, :, None, :]
    causal = jnp.tril(jnp.ones((SSM_CHUNK, SSM_CHUNK), dtype=bool))[:, :, None, None]
    decay = jnp.exp(jnp.where(causal, seg, -jnp.inf))
    cb = jnp.einsum('bclgn,bcsgn->bclsg', C, B)
    y_diag = jnp.einsum('bclsgr,bcsgrp->bclgrp', decay * cb[..., None], X)
    decay_to_end = jnp.exp(a_cs[:, :, -1:] - a_cs)
    states = jnp.einsum('bclgn,bclgrp->bcgrpn', B, X * decay_to_end[..., None])
    chunk_decay = jnp.exp(a_cs[:, :, -1])

    def step(h, inp):
        st, dec = inp
        return h * dec[..., None, None] + st, h

    h0 = jnp.zeros((b, g, r, p, n), F32)
    _, prev = lax.scan(step, h0, (jnp.moveaxis(states, 1, 0), jnp.moveaxis(chunk_decay, 1, 0)))
    prev = jnp.moveaxis(prev, 0, 1)
    y_off = jnp.einsum('bclgn,bcgrpn->bclgrp', C, prev) * jnp.exp(a_cs)[..., None]
    return (y_diag + y_off).reshape(b, s, g, r, p)


def mamba2_group(z, xbc, dt_raw, conv_w, conv_b, dt_bias, a_log, d_skip, ssm_norm):
    b, s, _ = z.shape
    G, R, P, N = SSM_GROUPS, SSM_HEADS_PER_GROUP, SSM_HEAD_DIM, SSM_STATE
    xbc = jax.nn.silu(causal_dwconv(xbc, conv_w, conv_b))
    xs, bm, cm = _split(xbc, [SSM_INNER, G * N, G * N])
    xf = xs.reshape(b, s, G, R, P).astype(F32)
    bm = bm.reshape(b, s, G, N).astype(F32)
    cm = cm.reshape(b, s, G, N).astype(F32)
    dt = jax.nn.softplus(dt_raw.astype(F32) + dt_bias.astype(F32)).reshape(b, s, G, R)
    a = -jnp.exp(a_log.astype(F32)).reshape(G, R)
    y = ssd_chunked(xf * dt[..., None], dt * a, bm, cm)
    y = y + xf * d_skip.astype(F32).reshape(G, R)[:, :, None]
    y = y * jax.nn.silu(z.astype(F32)).reshape(b, s, G, R, P)
    y = y.reshape(b, s, G, R * P)
    y = y * lax.rsqrt(jnp.mean(y * y, -1, keepdims=True) + NORM_EPS) * ssm_norm.astype(F32).reshape(G, R * P)
    return y.reshape(b, s, SSM_INNER).astype(z.dtype)


def swa_sink_attention(q, k, v, sinks):
    b, s, _, d = q.shape
    nb = s // ATTN_BLOCK
    grp = SWA_Q_HEADS // SWA_KV_HEADS
    qb = q.reshape(b, nb, ATTN_BLOCK, SWA_KV_HEADS, grp, d)

    def banded(t):
        t = t.reshape(b, nb, ATTN_BLOCK, SWA_KV_HEADS, d)
        prev = jnp.concatenate([jnp.zeros_like(t[:, :1]), t[:, :-1]], axis=1)
        return jnp.concatenate([prev, t], axis=2)

    kw, vw = banded(k), banded(v)
    logits = jnp.einsum('bnqkgd,bnskd->bnkgqs', qb, kw).astype(F32) * (d ** -0.5)
    qpos = jnp.arange(ATTN_BLOCK)[:, None] + ATTN_BLOCK
    kpos = jnp.arange(2 * ATTN_BLOCK)[None, :]
    rel = qpos - kpos
    band = (rel >= 0) & (rel < SWA_WINDOW)
    key_abs = jnp.arange(nb)[:, None] * ATTN_BLOCK + kpos - ATTN_BLOCK
    mask = band[None] & (key_abs >= 0)[:, None, :]
    logits = jnp.where(mask[None, :, None, None], logits, -jnp.inf)
    sink = sinks.astype(F32).reshape(SWA_KV_HEADS, grp)[None, None, :, :, None, None]
    m = jnp.maximum(logits.max(-1, keepdims=True), sink)
    e = jnp.exp(logits - m)
    prob = e / (e.sum(-1, keepdims=True) + jnp.exp(sink - m))
    out = jnp.einsum('bnkgqs,bnskd->bnqkgd', prob.astype(v.dtype), vw)
    return out.reshape(b, s, SWA_Q_HEADS * d)


def ssd_swa_mixer(x, cos, sin, w_in, conv_w, conv_b, dt_bias, a_log, d_skip, ssm_norm, sinks, w_out):
    b, s, _ = x.shape
    kvw = SWA_KV_HEADS * SWA_HEAD_DIM
    z, xbc, dt_raw, q, k, v = _split(x @ w_in, [SSM_INNER, SSM_CONV_DIM, SSM_HEADS,
                                                 SWA_Q_HEADS * SWA_HEAD_DIM, kvw, kvw])
    y_ssm = mamba2_group(z, xbc, dt_raw, conv_w, conv_b, dt_bias, a_log, d_skip, ssm_norm)
    q = apply_rope(q.reshape(b, s, SWA_Q_HEADS, SWA_HEAD_DIM), cos, sin)
    k = apply_rope(k.reshape(b, s, SWA_KV_HEADS, SWA_HEAD_DIM), cos, sin)
    v = v.reshape(b, s, SWA_KV_HEADS, SWA_HEAD_DIM)
    y_att = swa_sink_attention(q, k, v, sinks)
    return jnp.concatenate([y_ssm, y_att], axis=-1) @ w_out


def dsa_mla_mixer(x, cos, sin, w_in, kv_norm, w_uk, w_uv, w_out):
    b, s, _ = x.shape
    q, ckv, krope, qi, ki, wi = _split(x @ w_in, [MLA_HEADS * (MLA_NOPE + MLA_ROPE), MLA_RANK, MLA_ROPE,
                                                  IDX_HEADS * IDX_DIM, IDX_DIM, IDX_HEADS])
    q = q.reshape(b, s, MLA_HEADS, MLA_NOPE + MLA_ROPE)
    q_nope, q_rope = q[..., :MLA_NOPE], q[..., MLA_NOPE:]
    q_rope = apply_rope(q_rope, cos, sin)
    krope = apply_rope(krope[:, :, None, :], cos, sin)[:, :, 0]
    ckv = rms_norm(ckv, kv_norm)
    q_lat = jnp.einsum('bshd,hdr->bshr', q_nope, w_uk)
    qi = apply_rope(qi.reshape(b, s, IDX_HEADS, IDX_DIM), cos, sin)
    ki = apply_rope(ki[:, :, None, :], cos, sin)[:, :, 0]
    wi = wi * (IDX_HEADS ** -0.5 * IDX_DIM ** -0.5)
    topk = min(IDX_TOPK_MAX, s // 4)
    nb = s // ATTN_BLOCK
    key_pos = jnp.arange(s)
    bi = jnp.arange(b)[:, None, None]

    def blocks(t):
        return jnp.moveaxis(t.reshape(b, nb, ATTN_BLOCK, *t.shape[2:]), 1, 0)

    def attend(args):
        qi_b, wi_b, ql_b, qr_b, t_pos = args
        sc = jax.nn.relu(jnp.einsum('bqhd,bsd->bqhs', qi_b, ki))
        idx_score = jnp.einsum('bqhs,bqh->bqs', sc, wi_b).astype(F32)
        visible = key_pos[None, :] <= t_pos[:, None]
        idx_score = jnp.where(visible[None], idx_score, -jnp.inf)
        _, sel = lax.top_k(idx_score, topk)
        valid = sel <= t_pos[None, :, None]
        c_sel = ckv[bi, sel]
        kr_sel = krope[bi, sel]
        logits = (jnp.einsum('bqhr,bqkr->bqhk', ql_b, c_sel)
                  + jnp.einsum('bqhd,bqkd->bqhk', qr_b, kr_sel)).astype(F32) * MLA_SCALE
        logits = jnp.where(valid[:, :, None, :], logits, -jnp.inf)
        prob = jax.nn.softmax(logits, axis=-1).astype(c_sel.dtype)
        return jnp.einsum('bqhk,bqkr->bqhr', prob, c_sel)

    o_lat = lax.map(attend, (blocks(qi), blocks(wi), blocks(q_lat), blocks(q_rope),
                             jnp.arange(s).reshape(nb, ATTN_BLOCK)))
    o_lat = jnp.moveaxis(o_lat, 0, 1).reshape(b, s, MLA_HEADS, MLA_RANK)
    o = jnp.einsum('bshr,hrv->bshv', o_lat, w_uv).reshape(b, s, ODD_MIX)
    return o @ w_out


def hier_moe(x, r_group, r_group_b, r_expert, r_expert_b, w_gate, w_up, w_down):
    b, s, d = x.shape
    h = x.reshape(-1, d)
    t = h.shape[0]
    g_logits = (h @ r_group).astype(F32) + r_group_b.astype(F32)
    g_sel = jnp.argmax(g_logits, axis=-1)
    g_gate = jnp.take_along_axis(jax.nn.softmax(g_logits, axis=-1), g_sel[:, None], axis=-1)
    e_logits = ((h @ r_expert).astype(F32) + r_expert_b.astype(F32)).reshape(t, MOE_GROUPS, MOE_EXPERTS_PER_GROUP)
    e_logits = jnp.take_along_axis(e_logits, g_sel[:, None, None], axis=1)[:, 0]
    top_v, top_i = lax.top_k(e_logits, MOE_TOP_K)
    gate = jax.nn.softmax(top_v, axis=-1) * g_gate
    expert_id = (g_sel[:, None] * MOE_EXPERTS_PER_GROUP + top_i).reshape(-1)
    n = expert_id.shape[0]
    order = jnp.argsort(expert_id)
    sorted_e = expert_id[order]
    counts = jnp.bincount(expert_id, length=MOE_EXPERTS)
    padded = (counts + MOE_BLOCK - 1) // MOE_BLOCK * MOE_BLOCK
    pad_end = jnp.cumsum(padded)
    pad_start = pad_end - padded
    start = jnp.cumsum(counts) - counts
    dest = pad_start[sorted_e] + jnp.arange(n) - start[sorted_e]
    n_rows = n + MOE_EXPERTS * MOE_BLOCK
    row_token = jnp.full((n_rows,), t, jnp.int32).at[dest].set((order // MOE_TOP_K).astype(jnp.int32))
    h_pad = jnp.concatenate([h, jnp.zeros((1, d), h.dtype)], axis=0)
    xin = h_pad[row_token].reshape(n_rows // MOE_BLOCK, MOE_BLOCK, d)
    blk_start = jnp.arange(n_rows // MOE_BLOCK) * MOE_BLOCK
    blk_e = jnp.minimum(jnp.searchsorted(pad_end, blk_start, side='right'), MOE_EXPERTS - 1)

    def expert_block(args):
        xb, e = args
        hid = jax.nn.silu(xb @ w_gate[e]) * (xb @ w_up[e])
        return hid @ w_down[e]

    y_rows = lax.map(expert_block, (xin, blk_e)).reshape(n_rows, d)
    y_assign = jnp.zeros((n, d), y_rows.dtype).at[order].set(y_rows[dest])
    y = (y_assign.reshape(t, MOE_TOP_K, d) * gate[..., None].astype(y_rows.dtype)).sum(axis=1)
    return y.reshape(b, s, d)


def setup_inputs(seed: int = 0) -> dict:
    key = jax.random.key(seed)
    ks = iter(jax.random.split(key, 40))

    def nrm(shape, scale):
        return jax.random.normal(next(ks), shape, F32) * scale

    dt = jnp.exp(jax.random.uniform(next(ks), (N_EVEN, SSM_HEADS), F32)
                 * (np.log(0.1) - np.log(0.001)) + np.log(0.001))
    return {
        'x': nrm((BATCH, SEQ, D_MODEL), 1.0),
        'p': nrm((DEPTH, BATCH, SEQ, PLE_DIM), 1.0),
        'positions': (jax.random.randint(next(ks), (BATCH, 1), 0, 4096, jnp.int32)
                      + jnp.arange(SEQ, dtype=jnp.int32)[None, :]),
        'ev_w_in': nrm((N_EVEN, D_MODEL, EVEN_IN), D_MODEL ** -0.5),
        'ev_conv_w': nrm((N_EVEN, SSM_CONV, SSM_CONV_DIM), SSM_CONV ** -0.5),
        'ev_conv_b': nrm((N_EVEN, SSM_CONV_DIM), 0.01),
        'ev_dt_bias': dt + jnp.log(-jnp.expm1(-dt)),
        'ev_a_log': jnp.log(jax.random.uniform(next(ks), (N_EVEN, SSM_HEADS), F32, 1.0, 16.0)),
        'ev_d_skip': 1.0 + nrm((N_EVEN, SSM_HEADS), 0.01),
        'ev_ssm_norm': 1.0 + nrm((N_EVEN, SSM_INNER), 0.01),
        'ev_sinks': nrm((N_EVEN, SWA_Q_HEADS), 0.5),
        'ev_w_out': nrm((N_EVEN, EVEN_MIX, D_MODEL), EVEN_MIX ** -0.5 * DEEPNORM_BETA),
        'od_w_in': nrm((N_ODD, D_MODEL, ODD_IN), D_MODEL ** -0.5),
        'od_kv_norm': 1.0 + nrm((N_ODD, MLA_RANK), 0.01),
        'od_w_uk': nrm((N_ODD, MLA_HEADS, MLA_NOPE, MLA_RANK), MLA_RANK ** -0.5),
        'od_w_uv': nrm((N_ODD, MLA_HEADS, MLA_RANK, MLA_V), MLA_RANK ** -0.5),
        'od_w_out': nrm((N_ODD, ODD_MIX, D_MODEL), ODD_MIX ** -0.5 * DEEPNORM_BETA),
        'ln1_g': 1.0 + nrm((DEPTH, D_MODEL), 0.01),
        'ln1_b': nrm((DEPTH, D_MODEL), 0.01),
        'ln2_g': 1.0 + nrm((DEPTH, D_MODEL), 0.01),
        'ln2_b': nrm((DEPTH, D_MODEL), 0.01),
        'moe_router_group': nrm((DEPTH, D_MODEL, MOE_GROUPS), D_MODEL ** -0.5),
        'moe_router_group_b': nrm((DEPTH, MOE_GROUPS), 0.01),
        'moe_router_expert': nrm((DEPTH, D_MODEL, MOE_EXPERTS), D_MODEL ** -0.5),
        'moe_router_expert_b': nrm((DEPTH, MOE_EXPERTS), 0.01),
        'moe_w_gate': nrm((DEPTH, MOE_EXPERTS, D_MODEL, MOE_FF), D_MODEL ** -0.5),
        'moe_w_up': nrm((DEPTH, MOE_EXPERTS, D_MODEL, MOE_FF), D_MODEL ** -0.5),
        'moe_w_down': nrm((DEPTH, MOE_EXPERTS, MOE_FF, D_MODEL), MOE_FF ** -0.5 * DEEPNORM_BETA),
        'ple_w_proj': nrm((DEPTH, PLE_DIM, D_MODEL), PLE_DIM ** -0.5),
        'ple_w_gate': nrm((DEPTH, D_MODEL, D_MODEL), D_MODEL ** -0.5),
        'ple_b_gate': nrm((DEPTH, D_MODEL), 0.01),
    }


def reference(x, p, positions, ev_w_in, ev_conv_w, ev_conv_b, ev_dt_bias, ev_a_log, ev_d_skip,
              ev_ssm_norm, ev_sinks, ev_w_out, od_w_in, od_kv_norm, od_w_uk, od_w_uv, od_w_out,
              ln1_g, ln1_b, ln2_g, ln2_b, moe_router_group, moe_router_group_b, moe_router_expert,
              moe_router_expert_b, moe_w_gate, moe_w_up, moe_w_down, ple_w_proj, ple_w_gate, ple_b_gate):
    cos, sin = rope_tables(positions)
    for i in range(DEPTH):
        j = i // 2
        if i % 2 == 0:
            mix = ssd_swa_mixer(x, cos, sin, ev_w_in[j], ev_conv_w[j], ev_conv_b[j], ev_dt_bias[j],
                                ev_a_log[j], ev_d_skip[j], ev_ssm_norm[j], ev_sinks[j], ev_w_out[j])
        else:
            mix = dsa_mla_mixer(x, cos, sin, od_w_in[j], od_kv_norm[j], od_w_uk[j], od_w_uv[j], od_w_out[j])
        x = layer_norm(DEEPNORM_ALPHA * x + mix, ln1_g[i], ln1_b[i])
        ffn = hier_moe(x, moe_router_group[i], moe_router_group_b[i], moe_router_expert[i],
                       moe_router_expert_b[i], moe_w_gate[i], moe_w_up[i], moe_w_down[i])
        x = layer_norm(DEEPNORM_ALPHA * x + ffn, ln2_g[i], ln2_b[i])
        x = x + jax.nn.sigmoid(x @ ple_w_gate[i] + ple_b_gate[i]) * (p[i] @ ple_w_proj[i])
    return x
```

```cpp
#include <hip/hip_runtime.h>
#include <cstdio>
#include <cstdint>

#define GAS __attribute__((address_space(1)))
#define LAS __attribute__((address_space(3)))
typedef unsigned short bf16;
typedef short bf16x8 __attribute__((ext_vector_type(8)));
typedef short s16x4 __attribute__((ext_vector_type(4)));
typedef float f32x4 __attribute__((ext_vector_type(4)));
typedef float f32x2 __attribute__((ext_vector_type(2)));
typedef unsigned u32x4 __attribute__((ext_vector_type(4)));
typedef unsigned u32x2 __attribute__((ext_vector_type(2)));
typedef GAS unsigned gu32;

constexpr int T = 8192, D = 2048, DEPTH = 4;
constexpr int EV_IN = 6432, EV_INP = 6656, EV_MIX = 3072;
constexpr int OD_IN = 4752, OD_INP = 4864;
constexpr int NEXP = 32, FF = 512, CAP = 8192;
constexpr int MAXROWS = 24576;
constexpr float LN_EPS = 1e-5f;
constexpr float ALPHA = 1.681792830507429f;
constexpr float LOG2E = 1.4426950408889634f;
constexpr int UE_Z = 0, UE_XBC = 2048, UE_Q = 5120, UE_K = 6144, UE_V = 6272, UE_DT = 6400;
constexpr int UO_Q = 0, UO_CKV = 3072, UO_QI = 3584, UO_KR = 4608, UO_KI = 4672, UO_WI = 4736;
constexpr int QLD = 9216;
constexpr float MLA_QSCALE = 0.07216878364870322f * LOG2E;
constexpr float SWA_QSCALE = 0.125f * LOG2E;

constexpr size_t MiB = 1u << 20;
constexpr size_t WS_CTL = 0, CTL_ZERO_BYTES = 1 * MiB;
constexpr size_t WS_RT = 1 * MiB;
constexpr size_t WS_COS = 3 * MiB, WS_SIN = 4 * MiB;
constexpr size_t WS_ROUTE = 5 * MiB;
constexpr size_t WS_WIN_E = 8 * MiB;
constexpr size_t WS_WOUT_E = 60 * MiB;
constexpr size_t WS_WIN_O = 84 * MiB;
constexpr size_t WS_WUK = 122 * MiB;
constexpr size_t WS_WUV = 126 * MiB;
constexpr size_t WS_WOUT_O = 134 * MiB;
constexpr size_t WS_WPG = 150 * MiB;
constexpr size_t WS_WPP = 182 * MiB;
constexpr size_t WS_WGU = 186 * MiB;
constexpr size_t WS_WD = 698 * MiB;
constexpr size_t WS_X = 954 * MiB;
constexpr size_t WS_H = 1018 * MiB;
constexpr size_t WS_XB = 1082 * MiB;
constexpr size_t WS_PB = 1114 * MiB;
constexpr size_t WS_PP = 1130 * MiB;
constexpr size_t WS_U = 1162 * MiB;
constexpr size_t WS_HID = 1266 * MiB;
constexpr size_t WS_YROWS = 1290 * MiB;
constexpr size_t WS_LAYER = 1386 * MiB;
constexpr size_t WS_XC = WS_LAYER;
constexpr size_t WS_DT = WS_LAYER + 48 * MiB;
constexpr size_t WS_ACS = WS_LAYER + 49 * MiB;
constexpr size_t WS_STATES = WS_LAYER + 50 * MiB;
constexpr size_t WS_PREVB = WS_LAYER + 114 * MiB;
constexpr size_t WS_YMIX = WS_LAYER + 146 * MiB;
constexpr size_t WS_KV = WS_LAYER;
constexpr size_t WS_QI = WS_LAYER + 10 * MiB;
constexpr size_t WS_KI = WS_LAYER + 26 * MiB;
constexpr size_t WS_WI = WS_LAYER + 27 * MiB;
constexpr size_t WS_SEL = WS_LAYER + 28 * MiB;
constexpr size_t WS_O = WS_LAYER + 36 * MiB;
constexpr size_t WS_QL = WS_LAYER + 68 * MiB;
constexpr size_t WS_S = WS_LAYER + 212 * MiB;
constexpr size_t WS_OLAT = WS_S;
constexpr size_t WS_END = WS_LAYER + 468 * MiB;
constexpr size_t WS_XBN = WS_END;
constexpr size_t WS_TOTAL = WS_END + 32 * MiB;

constexpr int CW_TMO = 0, CW_CODE = 1;
constexpr int CW_BAR = 4096;
constexpr int CW_CNT = 16384;

constexpr int RING_BYTES = 131072;
constexpr int LDSCTL_OFF = 159744;
constexpr int MISC_OFF = LDSCTL_OFF + 320;
constexpr int MOE_TAB_OFF = LDSCTL_OFF + 512;
constexpr int LDS_BYTES = 161792;

#define RLX_AGENT __ATOMIC_RELAXED, __HIP_MEMORY_SCOPE_AGENT
#define LDS_WAIT() asm volatile("s_waitcnt lgkmcnt(0)" ::: "memory")
#define VM_WAIT() asm volatile("s_waitcnt vmcnt(0)" ::: "memory")

__device__ __forceinline__ unsigned f2bf(float f) { unsigned u = __builtin_bit_cast(unsigned, f); return (u + 0x7fffu + ((u >> 16) & 1u)) >> 16; }
__device__ __forceinline__ unsigned pk2(float lo, float hi) { return f2bf(lo) | (f2bf(hi) << 16); }
__device__ __forceinline__ float bf2f(unsigned short b) { return __builtin_bit_cast(float, ((unsigned)b) << 16); }
__device__ __forceinline__ float bflo(unsigned w) { return __builtin_bit_cast(float, w << 16); }
__device__ __forceinline__ float bfhi(unsigned w) { return __builtin_bit_cast(float, w & 0xffff0000u); }
#define dppf(old, v, ctrl, rmask) __builtin_bit_cast(float, __builtin_amdgcn_update_dpp(__builtin_bit_cast(int, (float)(old)), __builtin_bit_cast(int, (float)(v)), ctrl, rmask, 0xF, false))
#define DPP_ROW_REDUCE(v, OP) do { v = OP(v, dppf(v, v, 0xB1, 0xF)); v = OP(v, dppf(v, v, 0x4E, 0xF)); v = OP(v, dppf(v, v, 0x141, 0xF)); v = OP(v, dppf(v, v, 0x140, 0xF)); } while (0)
__device__ __forceinline__ float op_add(float a, float b) { return a + b; }
__device__ __forceinline__ float op_max(float a, float b) { return fmaxf(a, b); }
__device__ __forceinline__ float grp16_sum(float v) { DPP_ROW_REDUCE(v, op_add); return v; }
__device__ __forceinline__ float grp16_max(float v) { DPP_ROW_REDUCE(v, op_max); return v; }
__device__ __forceinline__ float wave_sum(float v) {
    DPP_ROW_REDUCE(v, op_add);
    v += dppf(0.f, v, 0x142, 0xA); v += dppf(0.f, v, 0x143, 0xC);
    return __builtin_bit_cast(float, __builtin_amdgcn_readlane(__builtin_bit_cast(int, v), 63));
}
__device__ __forceinline__ float wave_max(float v) {
    DPP_ROW_REDUCE(v, op_max);
    v = fmaxf(v, dppf(v, v, 0x142, 0xA)); v = fmaxf(v, dppf(v, v, 0x143, 0xC));
    return __builtin_bit_cast(float, __builtin_amdgcn_readlane(__builtin_bit_cast(int, v), 63));
}
__device__ __forceinline__ float siluf(float v) { return v / (1.f + __expf(-v)); }
__device__ __forceinline__ f32x4 mma16(bf16x8 a, bf16x8 b, f32x4 c) { return __builtin_amdgcn_mfma_f32_16x16x32_bf16(a, b, c, 0, 0, 0); }

namespace pg8 {
constexpr int BM = 256, BK = 64, HALF = 128, HTB = HALF * BK * 2, STAGE_BYTES = 8 * HTB;
constexpr int EPI_OFF = 131072, EPI_WAVE = 2304, EPI_P = 144;
__host__ __device__ __forceinline__ int lds_byte(int r, int c) { const int st = (r >> 4) * 2 + (c >> 5), rr = r & 15, cc = c & 31, ob = rr * 64 + cc * 2; return st * 1024 + (ob ^ (((ob >> 9) & 1) << 5)); }
__host__ __device__ __forceinline__ void stage_rc(int b, int& R, int& C) { const int st = b / 1024, sb = b % 1024, swz = sb ^ (((sb >> 9) & 1) << 5); R = (st >> 1) * 16 + swz / 64; C = (st & 1) * 32 + (swz % 64) / 2; }
__host__ __device__ __forceinline__ int perm32(int rho) { const int n = rho >> 4, i = rho & 15; return 8 * (i >> 2) + 4 * n + (i & 3); }

struct Unit { const char* pa; const char* pb; int m0, n0, aux, aux2; };
struct Gemm { int lda, ldb, K; };

__device__ __forceinline__ unsigned cvt_pk_bf16(float lo, float hi) { unsigned r; asm volatile("v_cvt_pk_bf16_f32 %0, %1, %2" : "=v"(r) : "v"(lo), "v"(hi)); return r; }


template <class Epi, class Sched, bool ALIGN_EPI, bool GATHER>
__device__ __forceinline__ void gemm_phase(LAS unsigned char* lds, const Gemm g, const Sched& S, const Epi& E, const int tid) {
    const int wid = __builtin_amdgcn_readfirstlane(tid >> 6), lane = tid & 63, wr = wid >> 2, wc = wid & 3, fr = lane & 15, fq = lane >> 4;
    const int K = g.K, nt = K / BK;
    unsigned voffA[2], voffB[2];
#pragma unroll
    for (int i = 0; i < 2; ++i) { int R, C; stage_rc(tid * 16 + i * 8192, R, C); const int Rb = Epi::PERM ? ((R & ~31) + perm32(R & 31)) : R;
        voffA[i] = GATHER ? 0u : (unsigned)(R * g.lda + C) * 2u; voffB[i] = (unsigned)(Rb * g.ldb + C) * 2u; }
    const size_t kstep = (size_t)(BK * 2);
    const size_t hstepA = (size_t)HALF * g.lda * 2, hstepB = (size_t)HALF * g.ldb * 2;
    const unsigned ldsw = (unsigned)wid * 1024u;
    const int aoff = lds_byte(wr * 64 + fr, fq * 8), boff = lds_byte(wc * 32 + fr, fq * 8);
#define PG8_SA(b, h) (((b) * 2 + (h)) * HTB)
#define PG8_SB(b, h) ((4 + (b) * 2 + (h)) * HTB)
#define PG8_GLDS(src, dstoff) __builtin_amdgcn_global_load_lds((const unsigned*)(src), (LAS unsigned*)(lds + (dstoff)), 16, 0, 0)
#define PG8_STAGE_B(bufoff, gbase, h) do { _Pragma("unroll") for (int _i = 0; _i < 2; ++_i) PG8_GLDS((const char*)(gbase) + (h) * hstepB + voffB[_i], (bufoff) + ldsw + _i * 8192); } while (0)
#define PG8_STAGE_A(bufoff, gbase, h, GV) do { _Pragma("unroll") for (int _i = 0; _i < 2; ++_i) { \
        if constexpr (GATHER) PG8_GLDS((const char*)(gbase) + GV[h][_i], (bufoff) + ldsw + _i * 8192); \
        else PG8_GLDS((const char*)(gbase) + (h) * hstepA + voffA[_i], (bufoff) + ldsw + _i * 8192); } } while (0)
#define PG8_LDA(dst, b, h) do { _Pragma("unroll") for (int m = 0; m < 4; ++m) _Pragma("unroll") for (int k = 0; k < 2; ++k) dst[m][k] = *(const LAS bf16x8*)(lds + PG8_SA(b, h) + aoff + m * 2048 + k * 1024); } while (0)
#define PG8_LDB(dst, b, h) do { _Pragma("unroll") for (int n = 0; n < 2; ++n) _Pragma("unroll") for (int k = 0; k < 2; ++k) dst[n][k] = *(const LAS bf16x8*)(lds + PG8_SB(b, h) + boff + n * 2048 + k * 1024); } while (0)
#define PG8_MMA(ai, bj, At, Bt) do { __builtin_amdgcn_s_setprio(1); _Pragma("unroll") for (int m = 0; m < 4; ++m) _Pragma("unroll") for (int n = 0; n < 2; ++n) _Pragma("unroll") for (int k = 0; k < 2; ++k) \
        acc[ai][bj][m][n] = __builtin_amdgcn_mfma_f32_16x16x32_bf16(Bt[n][k], At[m][k], acc[ai][bj][m][n], 0, 0, 0); __builtin_amdgcn_s_setprio(0); } while (0)
#define PG8_WAIT_V(n) asm volatile("s_waitcnt vmcnt(" #n ")" ::: "memory")
#define PG8_WAIT_L(n) asm volatile("s_waitcnt lgkmcnt(" #n ")" ::: "memory")
#define PG8_BAR __builtin_amdgcn_s_barrier()
#define PG8_SCHED __builtin_amdgcn_sched_barrier(0)
    Unit cur, nxt; int ui = 0;
    if (!S.next(0, cur)) return;
    f32x4 acc[2][2][4][2];
#pragma unroll
    for (int a = 0; a < 2; ++a)
#pragma unroll
        for (int b = 0; b < 2; ++b)
#pragma unroll
            for (int m = 0; m < 4; ++m)
#pragma unroll
                for (int n = 0; n < 2; ++n) acc[a][b][m][n] = (f32x4){0.f, 0.f, 0.f, 0.f};
    bf16x8 At[4][2], B0[2][2], B1[2][2];
    unsigned cvA[2][2], nvA[2][2];
    if constexpr (GATHER) {
#pragma unroll
        for (int h = 0; h < 2; ++h)
#pragma unroll
            for (int i = 0; i < 2; ++i) { int R, C; stage_rc(tid * 16 + i * 8192, R, C); cvA[h][i] = S.row_byteoff(cur, h * HALF + R) + (unsigned)(C * 2); nvA[h][i] = cvA[h][i]; }
    } else { cvA[0][0] = cvA[0][1] = cvA[1][0] = cvA[1][1] = 0u; nvA[0][0] = nvA[0][1] = nvA[1][0] = nvA[1][1] = 0u; }
    const char* cA = cur.pa; const char* cB = cur.pb;
    PG8_STAGE_B(PG8_SB(0, 0), cB, 0); PG8_STAGE_B(PG8_SB(0, 1), cB, 1); PG8_STAGE_A(PG8_SA(0, 0), cA, 0, cvA); PG8_STAGE_A(PG8_SA(0, 1), cA, 1, cvA);
    if (wr == 1) PG8_BAR;
    PG8_WAIT_V(2); PG8_BAR;
    PG8_STAGE_B(PG8_SB(1, 0), cB + kstep, 0); PG8_STAGE_A(PG8_SA(1, 0), cA + kstep, 0, cvA); PG8_STAGE_B(PG8_SB(1, 1), cB + kstep, 1);
    PG8_WAIT_V(6); PG8_BAR;
    for (;;) {
        const bool has_next = S.next(ui + 1, nxt);
        const char* nA = has_next ? nxt.pa : cA; const char* nB = has_next ? nxt.pb : cB;
        if constexpr (GATHER) {
            if (has_next) {
#pragma unroll
                for (int h = 0; h < 2; ++h)
#pragma unroll
                    for (int i = 0; i < 2; ++i) { int R, C; stage_rc(tid * 16 + i * 8192, R, C); nvA[h][i] = S.row_byteoff(nxt, h * HALF + R) + (unsigned)(C * 2); }
            }
        }
        for (int t = 0; t < nt; t += 2) {
            const bool last = (t == nt - 2);
            const char* a1 = cA + (size_t)(t + 1) * kstep;
            const char* a2 = last ? nA : cA + (size_t)(t + 2) * kstep; const char* b2 = last ? nB : cB + (size_t)(t + 2) * kstep;
            const char* a3 = a2 + kstep; const char* b3 = b2 + kstep;
            unsigned v2[2][2];
#pragma unroll
            for (int h = 0; h < 2; ++h)
#pragma unroll
                for (int i = 0; i < 2; ++i) v2[h][i] = last ? nvA[h][i] : cvA[h][i];
            PG8_LDB(B0, 0, 0); PG8_LDB(B1, 0, 1); PG8_SCHED; PG8_LDA(At, 0, 0); PG8_STAGE_A(PG8_SA(1, 1), a1, 1, cvA);
            PG8_WAIT_V(8); PG8_WAIT_L(0); PG8_BAR; PG8_MMA(0, 0, At, B0); PG8_MMA(0, 1, At, B1); PG8_BAR; PG8_SCHED;
            PG8_LDA(At, 0, 1); PG8_STAGE_B(PG8_SB(0, 0), b2, 0); PG8_STAGE_B(PG8_SB(0, 1), b2, 1); PG8_STAGE_A(PG8_SA(0, 0), a2, 0, v2);
            PG8_WAIT_V(8); PG8_WAIT_L(0); PG8_BAR; PG8_MMA(1, 0, At, B0); PG8_MMA(1, 1, At, B1); PG8_BAR; PG8_SCHED;
            PG8_LDB(B0, 1, 0); PG8_LDB(B1, 1, 1); PG8_SCHED; PG8_LDA(At, 1, 0); PG8_STAGE_A(PG8_SA(0, 1), a2, 1, v2);
            PG8_WAIT_V(8); PG8_WAIT_L(0); PG8_BAR; PG8_MMA(0, 0, At, B0); PG8_MMA(0, 1, At, B1); PG8_BAR; PG8_SCHED;
            PG8_LDA(At, 1, 1); PG8_STAGE_B(PG8_SB(1, 0), b3, 0); PG8_STAGE_B(PG8_SB(1, 1), b3, 1); PG8_STAGE_A(PG8_SA(1, 0), a3, 0, v2);
            PG8_WAIT_V(8); PG8_WAIT_L(0); PG8_BAR; PG8_MMA(1, 0, At, B0); PG8_MMA(1, 1, At, B1); PG8_BAR; PG8_SCHED;
        }
        if constexpr (ALIGN_EPI) { if (wr == 0) PG8_BAR; }
        { int tl = tid; asm volatile("" : "+v"(tl));
          E(acc, cur, wr, wc, fr, fq, lds + EPI_OFF + (tl >> 6) * EPI_WAVE, tl & 63); }
        if (!has_next) break;
#pragma unroll
        for (int a = 0; a < 2; ++a)
#pragma unroll
            for (int b = 0; b < 2; ++b)
#pragma unroll
                for (int m = 0; m < 4; ++m)
#pragma unroll
                    for (int n = 0; n < 2; ++n) acc[a][b][m][n] = (f32x4){0.f, 0.f, 0.f, 0.f};
        cur = nxt; cA = nA; cB = nB; ++ui;
        if constexpr (GATHER) {
#pragma unroll
            for (int h = 0; h < 2; ++h)
#pragma unroll
                for (int i = 0; i < 2; ++i) cvA[h][i] = nvA[h][i];
        }
        if constexpr (ALIGN_EPI) { if (wr == 1) PG8_BAR; }
    }
    PG8_WAIT_V(0);
    if constexpr (!ALIGN_EPI) { if (wr == 0) PG8_BAR; }
    PG8_BAR;
#undef PG8_SA
#undef PG8_SB
#undef PG8_GLDS
#undef PG8_STAGE_A
#undef PG8_STAGE_B
#undef PG8_LDA
#undef PG8_LDB
#undef PG8_MMA
#undef PG8_WAIT_V
#undef PG8_WAIT_L
#undef PG8_BAR
#undef PG8_SCHED
}

constexpr int NXCD = 8, WGM = 8;
__device__ __forceinline__ int xcd_remap(long L, int nwg) { int wgid = (int)L; const int q = nwg / NXCD, r = nwg % NXCD, xcd = wgid % NXCD, off = wgid / NXCD; return (xcd < r ? xcd * (q + 1) : r * (q + 1) + (xcd - r) * q) + off; }

struct SchedDense {
    int nM, nN, nwg, G, c; const char* A; const char* B; size_t a_tile, b_tile; int a_cdiv, a_cstride, n_div, n_stride;
    __device__ __forceinline__ void init(int nM_, int nN_, int G_, int c_, const void* A_, size_t a_tile_, const void* B_, size_t b_tile_) {
        nM = nM_; nN = nN_; nwg = nM * nN; G = G_; c = c_; A = (const char*)A_; B = (const char*)B_; a_tile = a_tile_; b_tile = b_tile_; a_cdiv = 1; a_cstride = 0; n_div = 1; n_stride = 256; }
    __device__ __forceinline__ bool next(int i, Unit& u) const {
        const long L = (long)i * G + c; if (L >= nwg) return false;
        const int wgid = xcd_remap(L, nwg);
        const int nig = WGM * nN, gid = wgid / nig, fm = gid * WGM, gsz = (nM - fm) < WGM ? (nM - fm) : WGM;
        const int pm = fm + ((wgid % nig) % gsz), pn = (wgid % nig) / gsz;
        u.pa = A + (size_t)pm * a_tile + (size_t)(pn / a_cdiv) * a_cstride; u.pb = B + (size_t)pn * b_tile;
        u.m0 = pm * BM; u.n0 = (pn / n_div) * n_stride + (pn % n_div) * BM; u.aux = 0; u.aux2 = 0; return true;
    }
};

template <int NPN, bool GATEUP> struct SchedMoe {
    const LAS int* tab; int nwg, G, c; const char* A; const char* W; size_t w_exp, w_tile; const int* rowtok;
    __device__ __forceinline__ void init(const LAS int* tab_, int G_, int c_, const void* A_, const void* W_, size_t w_exp_, size_t w_tile_, const int* rowtok_) {
        tab = tab_; nwg = tab_[32] * NPN; G = G_; c = c_; A = (const char*)A_; W = (const char*)W_; w_exp = w_exp_; w_tile = w_tile_; rowtok = rowtok_; }
    __device__ __forceinline__ bool next(int i, Unit& u) const {
        const long L = (long)i * G + c; if (L >= nwg) return false;
        const int wgid = xcd_remap(L, nwg);
        int e = 0;
#pragma unroll 1
        for (int k = 16; k >= 1; k >>= 1) if (e + k < 32 && tab[e + k] * NPN <= wgid) e += k;
        const int loc = wgid - tab[e] * NPN, nte = tab[e + 1] - tab[e], pn = loc / nte, ti = loc % nte;
        const int rowbase = (tab[e] + ti) * BM;
        u.m0 = rowbase; u.aux = e; u.aux2 = ti * BM;
        if (GATEUP) { u.pa = A; u.pb = W + (size_t)e * w_exp + (size_t)pn * w_tile; u.n0 = pn * 128; }
        else { u.pa = A + (size_t)rowbase * FF * 2; u.pb = W + (size_t)e * w_exp + (size_t)pn * w_tile; u.n0 = pn * BM; }
        return true;
    }
    __device__ __forceinline__ unsigned row_byteoff(const Unit& u, int r) const {
        const int pos = u.aux2 + r; const int cnt = tab[40 + u.aux];
        const int tok = pos < cnt ? rowtok[u.aux * CAP + pos] : 0;
        return (unsigned)tok * (unsigned)(D * 2);
    }
};

__device__ __forceinline__ void epi_tile_bf16(LAS unsigned char* st, const u32x4 w0, const u32x4 w1, bf16* O, const size_t ldc, const int lane, const int fr, const int fq) {
    *(LAS u32x4*)(st + fr * EPI_P + fq * 16) = w0; *(LAS u32x4*)(st + fr * EPI_P + 64 + fq * 16) = w1;
    const int r = lane >> 3, sg = (lane >> 2) & 1, c = lane & 3;
    const u32x4 a = *(const LAS u32x4*)(st + r * EPI_P + sg * 64 + c * 16), b = *(const LAS u32x4*)(st + (r + 8) * EPI_P + sg * 64 + c * 16);
    *(u32x4*)(O + (size_t)r * ldc + sg * HALF + c * 8) = a; *(u32x4*)(O + (size_t)(r + 8) * ldc + sg * HALF + c * 8) = b;
}
struct EpiBf16 {
    static constexpr bool PERM = true;
    bf16* O; int ldc; float scale;
    __device__ __forceinline__ void operator()(const f32x4 (&acc)[2][2][4][2], const Unit& u, int wr, int wc, int fr, int fq, LAS unsigned char* st, int lane) const {
#pragma unroll
        for (int ai = 0; ai < 2; ++ai)
#pragma unroll
            for (int m = 0; m < 4; ++m) { u32x4 w[2];
#pragma unroll
                for (int bj = 0; bj < 2; ++bj) { const f32x4 v0 = acc[ai][bj][m][0] * scale, v1 = acc[ai][bj][m][1] * scale;
                    w[bj].x = cvt_pk_bf16(v0[0], v0[1]); w[bj].y = cvt_pk_bf16(v0[2], v0[3]); w[bj].z = cvt_pk_bf16(v1[0], v1[1]); w[bj].w = cvt_pk_bf16(v1[2], v1[3]); }
                epi_tile_bf16(st, w[0], w[1], O + (size_t)(u.m0 + wr * 64 + ai * HALF + m * 16) * ldc + u.n0 + wc * 32, (size_t)ldc, lane, fr, fq); }
    }
};
struct EpiGateUp {
    static constexpr bool PERM = true;
    bf16* O;
    __device__ __forceinline__ void operator()(const f32x4 (&acc)[2][2][4][2], const Unit& u, int wr, int wc, int fr, int fq, LAS unsigned char* st, int lane) const {
        const int r = lane >> 2, c = lane & 3;
#pragma unroll
        for (int ai = 0; ai < 2; ++ai)
#pragma unroll
            for (int m = 0; m < 4; ++m) {
                f32x4 h0, h1;
#pragma unroll
                for (int k = 0; k < 4; ++k) { h0[k] = siluf(acc[ai][0][m][0][k]) * acc[ai][1][m][0][k]; h1[k] = siluf(acc[ai][0][m][1][k]) * acc[ai][1][m][1][k]; }
                u32x4 w; w.x = cvt_pk_bf16(h0[0], h0[1]); w.y = cvt_pk_bf16(h0[2], h0[3]); w.z = cvt_pk_bf16(h1[0], h1[1]); w.w = cvt_pk_bf16(h1[2], h1[3]);
                *(LAS u32x4*)(st + fr * EPI_P + fq * 16) = w;
                const u32x4 a = *(const LAS u32x4*)(st + r * EPI_P + c * 16);
                *(u32x4*)(O + (size_t)(u.m0 + wr * 64 + ai * HALF + m * 16 + r) * FF + u.n0 + wc * 32 + c * 8) = a; }
    }
};
struct EpiDown {
    static constexpr bool PERM = true;
    bf16* O; const float* rowgate; const LAS int* tab;
    __device__ __forceinline__ void operator()(const f32x4 (&acc)[2][2][4][2], const Unit& u, int wr, int wc, int fr, int fq, LAS unsigned char* st, int lane) const {
        const int rl0 = wr * 64 + fr; const int cnt = tab[40 + u.aux];
#pragma unroll
        for (int ai = 0; ai < 2; ++ai)
#pragma unroll
            for (int m = 0; m < 4; ++m) { const int rl = rl0 + ai * HALF + m * 16, pos = u.aux2 + rl;
                const float gt = pos < cnt ? rowgate[u.aux * CAP + pos] : 0.f;
                u32x4 w[2];
#pragma unroll
                for (int bj = 0; bj < 2; ++bj) { const f32x4 v0 = acc[ai][bj][m][0] * gt, v1 = acc[ai][bj][m][1] * gt;
                    w[bj].x = cvt_pk_bf16(v0[0], v0[1]); w[bj].y = cvt_pk_bf16(v0[2], v0[3]); w[bj].z = cvt_pk_bf16(v1[0], v1[1]); w[bj].w = cvt_pk_bf16(v1[2], v1[3]); }
                epi_tile_bf16(st, w[0], w[1], O + (size_t)(u.m0 + wr * 64 + ai * HALF + m * 16) * D + u.n0 + wc * 32, (size_t)D, lane, fr, fq); }
    }
};
struct EpiRes {
    static constexpr bool PERM = false;
    const bf16* XR; bf16* Hout;
    __device__ __forceinline__ void operator()(const f32x4 (&acc)[2][2][4][2], const Unit& u, int wr, int wc, int fr, int fq, LAS unsigned char* st, int lane) const {
        const int r = lane >> 2, c = lane & 3;
        const size_t off0 = (size_t)(u.m0 + wr * 64 + r) * D + u.n0 + wc * 32 + c * 8;
        u32x4 xr[2][2];
        xr[0][0] = *(const u32x4*)(XR + off0); xr[0][1] = *(const u32x4*)(XR + off0 + HALF);
#pragma unroll
        for (int it = 0; it < 8; ++it) { const int ai = it >> 2, m = it & 3; const size_t off = off0 + (size_t)(ai * HALF + m * 16) * D;
            if (it < 7) { const size_t offn = off0 + (size_t)(((it + 1) >> 2) * HALF + ((it + 1) & 3) * 16) * D; xr[(it + 1) & 1][0] = *(const u32x4*)(XR + offn); xr[(it + 1) & 1][1] = *(const u32x4*)(XR + offn + HALF); }
#pragma unroll
            for (int bj = 0; bj < 2; ++bj) {
                *(LAS f32x4*)(st + fr * EPI_P + fq * 16) = acc[ai][bj][m][0]; *(LAS f32x4*)(st + fr * EPI_P + 64 + fq * 16) = acc[ai][bj][m][1];
                const f32x4 v0 = *(const LAS f32x4*)(st + r * EPI_P + c * 32), v1 = *(const LAS f32x4*)(st + r * EPI_P + c * 32 + 16);
                const u32x4 xw = xr[it & 1][bj];
                u32x4 hw2; hw2.x = cvt_pk_bf16(bflo(xw.x) * ALPHA + v0[0], bfhi(xw.x) * ALPHA + v0[1]); hw2.y = cvt_pk_bf16(bflo(xw.y) * ALPHA + v0[2], bfhi(xw.y) * ALPHA + v0[3]);
                hw2.z = cvt_pk_bf16(bflo(xw.z) * ALPHA + v1[0], bfhi(xw.z) * ALPHA + v1[1]); hw2.w = cvt_pk_bf16(bflo(xw.w) * ALPHA + v1[2], bfhi(xw.w) * ALPHA + v1[3]);
                *(u32x4*)(Hout + off + bj * HALF) = hw2; }
            asm volatile("" ::: "memory"); }
    }
};
struct EpiPle {
    static constexpr bool PERM = false;
    const bf16* XR; float* Xout; bf16* XBout; const bf16* PP; const float* bg;
    __device__ __forceinline__ void operator()(const f32x4 (&acc)[2][2][4][2], const Unit& u, int wr, int wc, int fr, int fq, LAS unsigned char* st, int lane) const {
        const int r = lane >> 2, c = lane & 3;
        const int colb = u.n0 + wc * 32 + c * 8;
        const size_t off0 = (size_t)(u.m0 + wr * 64 + r) * D + colb;
        f32x4 bv[2][2];
#pragma unroll
        for (int bj = 0; bj < 2; ++bj) { bv[bj][0] = *(const f32x4*)(bg + colb + bj * HALF); bv[bj][1] = *(const f32x4*)(bg + colb + bj * HALF + 4); }
        u32x4 xr[2][2], pr[2][2];
        xr[0][0] = *(const u32x4*)(XR + off0); xr[0][1] = *(const u32x4*)(XR + off0 + HALF); pr[0][0] = *(const u32x4*)(PP + off0); pr[0][1] = *(const u32x4*)(PP + off0 + HALF);
#pragma unroll
        for (int it = 0; it < 8; ++it) { const int ai = it >> 2, m = it & 3; const size_t off = off0 + (size_t)(ai * HALF + m * 16) * D;
            if (it < 7) { const size_t offn = off0 + (size_t)(((it + 1) >> 2) * HALF + ((it + 1) & 3) * 16) * D;
                xr[(it + 1) & 1][0] = *(const u32x4*)(XR + offn); xr[(it + 1) & 1][1] = *(const u32x4*)(XR + offn + HALF); pr[(it + 1) & 1][0] = *(const u32x4*)(PP + offn); pr[(it + 1) & 1][1] = *(const u32x4*)(PP + offn + HALF); }
#pragma unroll
            for (int bj = 0; bj < 2; ++bj) {
                *(LAS f32x4*)(st + fr * EPI_P + fq * 16) = acc[ai][bj][m][0]; *(LAS f32x4*)(st + fr * EPI_P + 64 + fq * 16) = acc[ai][bj][m][1];
                const f32x4 a0 = *(const LAS f32x4*)(st + r * EPI_P + c * 32) + bv[bj][0], a1 = *(const LAS f32x4*)(st + r * EPI_P + c * 32 + 16) + bv[bj][1];
                const u32x4 xw = xr[it & 1][bj], pw = pr[it & 1][bj]; f32x4 o0, o1;
                o0[0] = bflo(xw.x) + bflo(pw.x) / (1.f + __expf(-a0[0])); o0[1] = bfhi(xw.x) + bfhi(pw.x) / (1.f + __expf(-a0[1]));
                o0[2] = bflo(xw.y) + bflo(pw.y) / (1.f + __expf(-a0[2])); o0[3] = bfhi(xw.y) + bfhi(pw.y) / (1.f + __expf(-a0[3]));
                o1[0] = bflo(xw.z) + bflo(pw.z) / (1.f + __expf(-a1[0])); o1[1] = bfhi(xw.z) + bfhi(pw.z) / (1.f + __expf(-a1[1]));
                o1[2] = bflo(xw.w) + bflo(pw.w) / (1.f + __expf(-a1[2])); o1[3] = bfhi(xw.w) + bfhi(pw.w) / (1.f + __expf(-a1[3]));
                if (Xout) { *(f32x4*)(Xout + off + bj * HALF) = o0; *(f32x4*)(Xout + off + bj * HALF + 4) = o1; }
                u32x4 w; w.x = cvt_pk_bf16(o0[0], o0[1]); w.y = cvt_pk_bf16(o0[2], o0[3]); w.z = cvt_pk_bf16(o1[0], o1[1]); w.w = cvt_pk_bf16(o1[2], o1[3]);
                *(u32x4*)(XBout + off + bj * HALF) = w; }
            asm volatile("" ::: "memory"); }
    }
};
}

#define XB_TMO      128
#define XB_XCNT(j)  (256  + 64 * (j))
#define XB_XSUB(j)  (1280 + 64 * (j))
#define XB_XGEN(j)  (2304 + 64 * (j))
#define XB_TOP      3328
#define XB_TOPGEN   3392
#define XCD_BAR_WORDS 3456
#define XB_SPIN_CAP (1u << 18)

__device__ __forceinline__ unsigned xb_ld(unsigned* p)              { return __hip_atomic_load(p, __ATOMIC_RELAXED, __HIP_MEMORY_SCOPE_AGENT); }
__device__ __forceinline__ unsigned xb_add(unsigned* p, unsigned v) { return __hip_atomic_fetch_add(p, v, __ATOMIC_RELAXED, __HIP_MEMORY_SCOPE_AGENT); }
__device__ __forceinline__ unsigned xb_xcc_id() { return (unsigned)__builtin_amdgcn_s_getreg((3 << 11) | 20) & 0xFu; }
#define XB_SPIN(cond, bar) do { unsigned _sp = 0; while (cond) { __builtin_amdgcn_s_sleep(1); \
    if ((++_sp & 255u) == 0u) { if (xb_ld(&(bar)[XB_TMO])) break; if (_sp > XB_SPIN_CAP) { atomicAdd(&(bar)[XB_TMO], 1u); break; } } } } while (0)

struct XcdBarrier { unsigned* bar; unsigned x; volatile LAS unsigned* st; };

__device__ __forceinline__ XcdBarrier xcd_barrier_post(unsigned* bar, volatile LAS unsigned* st) {
    XcdBarrier b; b.bar = bar; b.x = xb_xcc_id(); b.st = st;
    if (threadIdx.x == 0) (void)xb_add(&bar[XB_XCNT(b.x)], 1u);
    return b;
}
__device__ __forceinline__ void xcd_barrier_complete(unsigned* bar, unsigned x, unsigned& nloc, unsigned& nx) {
    const unsigned G = gridDim.x * gridDim.y * gridDim.z;
    unsigned sum, cnt, mine, sp = 0u;
    for (;;) {
        sum = 0u; cnt = 0u; mine = 0u;
#pragma unroll
        for (unsigned j = 0; j < 16; ++j) { const unsigned c = xb_ld(&bar[XB_XCNT(j)]); sum += c; cnt += (c > 0u) ? 1u : 0u; mine = (j == x) ? c : mine; }
        if (sum == G) break;
        __builtin_amdgcn_s_sleep(1);
        if ((++sp & 255u) == 0u) { if (xb_ld(&bar[XB_TMO])) break; if (sp > XB_SPIN_CAP) { atomicAdd(&bar[XB_TMO], 1u); break; } }
    }
    nloc = mine > 0u ? mine : 1u; nx = cnt > 0u ? cnt : 1u;
}
__device__ __forceinline__ void xcd_barrier(const XcdBarrier& b) {
    asm volatile("s_waitcnt vmcnt(0)" ::: "memory");
    __syncthreads();
    if (threadIdx.x == 0) {
        unsigned* bar = b.bar;
        __builtin_amdgcn_s_waitcnt(0);
        unsigned nloc = b.st[0], nx = b.st[1];
        if (nloc == 0u) { xcd_barrier_complete(bar, b.x, nloc, nx); b.st[0] = nloc; b.st[1] = nx; }
        const unsigned old = xb_add(&bar[XB_XSUB(b.x)], 1u);
        const unsigned gen = old / nloc;
        if (old + 1u == (gen + 1u) * nloc) {
            __builtin_amdgcn_fence(__ATOMIC_RELEASE, "agent");
            asm volatile("s_waitcnt vmcnt(0)" ::: "memory");
            const unsigned og = xb_add(&bar[XB_TOP], 1u);
            const unsigned tg = og / nx;
            if (og + 1u == (tg + 1u) * nx) xb_add(&bar[XB_TOPGEN], 1u);
            else XB_SPIN(xb_ld(&bar[XB_TOPGEN]) == tg, bar);
            __builtin_amdgcn_fence(__ATOMIC_ACQUIRE, "agent");
            xb_add(&bar[XB_XGEN(b.x)], 1u);
            asm volatile("s_waitcnt vmcnt(0)" ::: "memory");
        } else {
            XB_SPIN(xb_ld(&bar[XB_XGEN(b.x)]) == gen, bar);
            __builtin_amdgcn_fence(__ATOMIC_ACQUIRE, "agent");
            asm volatile("s_waitcnt vmcnt(0)" ::: "memory");
        }
    }
    __syncthreads();
}

struct Frame {
    LAS unsigned char* lds;
    int tid, lane, wave;
    int G, cid, gw, NGW;
    unsigned char* ws;
    const __attribute__((address_space(4))) unsigned char* ka;
};
#define F_CTL ((gu32*)(F.ws + WS_CTL))
#define F_OUT (*(float* const __attribute__((address_space(4)))*)(F.ka + 248))
#define WSP(T_, off) ((T_*)(F.ws + (off)))
#define FIN(k) (*(const float* const __attribute__((address_space(4)))*)(F.ka + 8 * (k)))
#define PHASE_BEGIN() do { asm volatile("" : "+s"(F.ws)); asm volatile("" : "+s"(F.ka)); asm volatile("" : "+s"(F.wave)); asm volatile("" : "+s"(F.G)); asm volatile("" : "+s"(F.cid)); \
    { int z_; asm volatile("s_mov_b32 %0, 0" : "=s"(z_)); F.lane = (int)__builtin_amdgcn_mbcnt_hi(~0u, __builtin_amdgcn_mbcnt_lo(~0u, (unsigned)z_)); } \
    F.tid = F.wave * 64 + F.lane; F.gw = F.cid * 8 + F.wave; F.NGW = F.G * 8; } while (0)

__device__ __forceinline__ void tr_item(const float* W, int ldw, int col0, int nvalid, int k0, bf16* dst, int dst_ld, LAS float* scr, int lane) {
    const int cl = lane & 31;
    { float tv[32]; const float* wp = W + (size_t)(k0 + (lane >> 5)) * ldw + col0 + cl;
#pragma unroll
      for (int i = 0; i < 32; ++i) tv[i] = (cl < nvalid) ? __builtin_nontemporal_load(wp + (size_t)(2 * i) * ldw) : 0.f;
#pragma unroll
      for (int i = 0; i < 32; ++i) scr[(2 * i + (lane >> 5)) * 33 + cl] = tv[i]; }
    LDS_WAIT(); asm volatile("" ::: "memory");
    const int c = lane & 7;
#pragma unroll
    for (int j = 0; j < 4; ++j) { const int n = (lane >> 3) + 8 * j; const LAS float* s = scr + (8 * c) * 33 + n;
        u32x4 o; o.x = pk2(s[0 * 33], s[1 * 33]); o.y = pk2(s[2 * 33], s[3 * 33]); o.z = pk2(s[4 * 33], s[5 * 33]); o.w = pk2(s[6 * 33], s[7 * 33]);
        *(GAS u32x4*)(dst + (size_t)n * dst_ld + 8 * c) = o; }
    LDS_WAIT(); asm volatile("" ::: "memory");
}
__device__ __forceinline__ void zero_item(bf16* dst, int dst_ld, int lane) {
    const int c = lane & 7;
#pragma unroll
    for (int j = 0; j < 4; ++j) { const int n = (lane >> 3) + 8 * j; *(GAS u32x4*)(dst + (size_t)n * dst_ld + 8 * c) = (u32x4){0u, 0u, 0u, 0u}; }
}

constexpr int MOE_ITEMS = 49152, MOE_SEG0 = 8192, MOE_SEG1 = 16384;
__device__ __forceinline__ void moe_cvt(Frame& F, int l, int q, LAS float* scr) {
    const int mat = q >> 14, rr0 = q & 16383, e = rr0 >> 9, rr = rr0 & 511, le = l * 32 + e;
    if (mat < 2) { const int nb = rr % 16, kb = rr / 16;
        const float* W = FIN(mat ? 26 : 25) + (size_t)le * 2048 * 512;
        bf16* dst = WSP(bf16, WS_WGU) + (size_t)le * 1024 * 2048 + (size_t)((nb >> 2) * 256 + (nb & 3) * 32 + mat * 128) * 2048 + kb * 64;
        tr_item(W, 512, nb * 32, 32, kb * 64, dst, 2048, scr, F.lane);
    } else { const int nb = rr % 64, kb = rr / 64;
        const float* W = FIN(27) + (size_t)le * 512 * 2048;
        bf16* dst = WSP(bf16, WS_WD) + (size_t)le * 2048 * 512 + (size_t)(nb * 32) * 512 + kb * 64;
        tr_item(W, 2048, nb * 32, 32, kb * 64, dst, 512, scr, F.lane); }
}
__device__ __forceinline__ void moe_cvt_tail(Frame& F, int nwg, int l, int q0, int q1) {
    const int rem = nwg % F.G; int rank, nr;
    if (rem == 0) { rank = F.cid; nr = F.G; } else { if (F.cid < rem) return; rank = F.cid - rem; nr = F.G - rem; }
    LAS float* scr = (LAS float*)(F.lds + F.wave * 16384);
    for (int q = q0 + rank * 8 + F.wave; q < q1; q += nr * 8) moe_cvt(F, l, q, scr);
}
__device__ __forceinline__ void p0_prologue(Frame& F) {
    LAS float* scr = (LAS float*)(F.lds + F.wave * 16384);
    const int lane = F.lane;
    constexpr int N_EVIN = 2 * 208 * 32, N_EVOUT = 2 * 64 * 48, N_ODIN = 2 * 152 * 32, N_ODOUT = 2 * 64 * 32, N_UK = 2 * 16 * 16 * 2, N_UV = 2 * 16 * 4 * 8;
    constexpr int N_MOE = (MOE_ITEMS - MOE_SEG0) + 3 * (MOE_ITEMS - MOE_SEG1), N_PG = 4 * 64 * 32, N_PPW = 4 * 64 * 4;
    constexpr int NITEMS = N_EVIN + N_EVOUT + N_ODIN + N_ODOUT + N_UK + N_UV + N_MOE + N_PG + N_PPW;
    for (int it = F.gw; it < NITEMS; it += F.NGW) {
        int r = it;
        if (r < N_MOE) {
            constexpr int N0 = MOE_ITEMS - MOE_SEG0, N1 = MOE_ITEMS - MOE_SEG1;
            int l, q; if (r < N0) { l = 0; q = MOE_SEG0 + r; } else { const int r2 = r - N0; l = 1 + r2 / N1; q = MOE_SEG1 + r2 % N1; }
            moe_cvt(F, l, q, scr); continue; }
        r -= N_MOE;
        if (r < N_EVIN) {
            const int j = r / (208 * 32), rr = r % (208 * 32), nb = rr % 208, kb = rr / 208, n0 = nb * 32;
            int src; if (n0 < 5120) src = n0; else if (n0 < 6144) src = n0 - 5120 + 5152; else if (n0 < 6272) src = n0 - 6144 + 6176; else if (n0 < 6400) src = n0 - 6272 + 6304; else if (n0 < 6432) src = 5120 + (n0 - 6400); else src = -1;
            bf16* dst = WSP(bf16, WS_WIN_E) + (size_t)j * EV_INP * 2048 + (size_t)n0 * 2048 + kb * 64;
            if (src < 0) zero_item(dst, 2048, lane); else tr_item(FIN(3) + (size_t)j * 2048 * EV_IN, EV_IN, src, 32, kb * 64, dst, 2048, scr, lane);
            continue; }
        r -= N_EVIN;
        if (r < N_EVOUT) {
            const int j = r / (64 * 48), rr = r % (64 * 48), nb = rr % 64, kb = rr / 64;
            tr_item(FIN(11) + (size_t)j * 3072 * 2048, 2048, nb * 32, 32, kb * 64, WSP(bf16, WS_WOUT_E) + (size_t)j * 2048 * 3072 + (size_t)(nb * 32) * 3072 + kb * 64, 3072, scr, lane); continue; }
        r -= N_EVOUT;
        if (r < N_ODIN) {
            const int j = r / (152 * 32), rr = r % (152 * 32), nb = rr % 152, kb = rr / 152, n0 = nb * 32;
            int src, nv = 32; if (n0 < 3584) src = n0; else if (n0 < 4608) src = n0 - 3584 + 3648; else if (n0 < 4672) src = n0 - 4608 + 3584; else if (n0 < 4736) src = n0; else if (n0 < 4768) { src = 4736; nv = 16; } else src = -1;
            bf16* dst = WSP(bf16, WS_WIN_O) + (size_t)j * OD_INP * 2048 + (size_t)n0 * 2048 + kb * 64;
            if (src < 0) zero_item(dst, 2048, lane); else tr_item(FIN(12) + (size_t)j * 2048 * OD_IN, OD_IN, src, nv, kb * 64, dst, 2048, scr, lane);
            continue; }
        r -= N_ODIN;
        if (r < N_ODOUT) {
            const int j = r / (64 * 32), rr = r % (64 * 32), nb = rr % 64, kb = rr / 64;
            tr_item(FIN(16) + (size_t)j * 2048 * 2048, 2048, nb * 32, 32, kb * 64, WSP(bf16, WS_WOUT_O) + (size_t)j * 2048 * 2048 + (size_t)(nb * 32) * 2048 + kb * 64, 2048, scr, lane); continue; }
        r -= N_ODOUT;
        if (r < N_UK) {
            const int jh = r / 32, rr = r % 32, nb = rr / 2, kb = rr % 2;
            tr_item(FIN(14) + (size_t)jh * 128 * 512, 512, nb * 32, 32, kb * 64, WSP(bf16, WS_WUK) + (size_t)jh * 512 * 128 + (size_t)(nb * 32) * 128 + kb * 64, 128, scr, lane); continue; }
        r -= N_UK;
        if (r < N_UV) {
            const int jh = r / 32, rr = r % 32, nb = rr / 8, kb = rr % 8, h = jh & 15;
            bf16* drow = WSP(bf16, WS_WUV) + (size_t)(jh >> 4) * 2048 * 1024 + (size_t)(h * 128 + nb * 32) * 1024;
            tr_item(FIN(15) + (size_t)jh * 512 * 128, 128, nb * 32, 32, kb * 64, drow + (h & 1) * 512 + kb * 64, 1024, scr, lane);
            zero_item(drow + ((h & 1) ^ 1) * 512 + kb * 64, 1024, lane); continue; }
        r -= N_UV;
        if (r < N_PG) {
            const int l = r / (64 * 32), rr = r % (64 * 32), nb = rr % 64, kb = rr / 64;
            tr_item(FIN(29) + (size_t)l * 2048 * 2048, 2048, nb * 32, 32, kb * 64, WSP(bf16, WS_WPG) + (size_t)l * 2048 * 2048 + (size_t)(nb * 32) * 2048 + kb * 64, 2048, scr, lane); continue; }
        r -= N_PG;
        {
            const int l = r / (64 * 4), rr = r % (64 * 4), nb = rr / 4, kb = rr % 4;
            tr_item(FIN(28) + (size_t)l * 256 * 2048, 2048, nb * 32, 32, kb * 64, WSP(bf16, WS_WPP) + (size_t)l * 2048 * 256 + (size_t)(nb * 32) * 256 + kb * 64, 256, scr, lane); }
    }
    const size_t gt = (size_t)F.gw * 64 + lane, NT = (size_t)F.NGW * 64;
    { const f32x4* xs = (const f32x4*)FIN(0); u32x2* xb = WSP(u32x2, WS_XBN);
      for (size_t i = gt; i < (size_t)T * D / 4; i += NT) { const f32x4 v = xs[i]; u32x2 w; w.x = pk2(v[0], v[1]); w.y = pk2(v[2], v[3]); xb[i] = w; } }
    { const f32x4* ps = (const f32x4*)FIN(1); u32x2* pb = WSP(u32x2, WS_PB);
      for (size_t i = gt; i < (size_t)DEPTH * T * 256 / 4; i += NT) { const f32x4 v = ps[i]; u32x2 w; w.x = pk2(v[0], v[1]); w.y = pk2(v[2], v[3]); pb[i] = w; } }
    { float* rt = WSP(float, WS_RT);
      for (size_t i = gt; i < (size_t)DEPTH * 36 * D; i += NT) { const int d = (int)(i % D), e = (int)((i / D) % 36), l = (int)(i / ((size_t)36 * D));
          rt[i] = e < 4 ? FIN(21)[((size_t)l * D + d) * 4 + e] : FIN(23)[((size_t)l * D + d) * 32 + (e - 4)]; } }
    { float* cs = WSP(float, WS_COS); float* sn = WSP(float, WS_SIN); const int* pos = (const int*)FIN(2);
      for (size_t i = gt; i < (size_t)T * 32; i += NT) { const int t = (int)(i >> 5), k = (int)(i & 31);
          const float inv = powf(10000.0f, -(float)(2 * k) / 64.0f); const float ang = (float)pos[t] * inv;
          cs[i] = (float)cos((double)ang); sn[i] = (float)sin((double)ang); } }
}

__device__ __forceinline__ float wave_incl_scan(float v, int lane) {
#pragma unroll
    for (int o = 1; o < 64; o <<= 1) { const float t = __shfl_up(v, o); if (lane >= o) v += t; }
    return v;
}
__device__ __forceinline__ void even_conv(Frame& F, int j) {
    const bf16* U = WSP(bf16, WS_U); bf16* XC = WSP(bf16, WS_XC);
    const float* cw = FIN(4) + (size_t)j * 4 * 3072; const float* cb = FIN(5) + (size_t)j * 3072;
    const size_t gt = (size_t)F.gw * 64 + F.lane, NT = (size_t)F.NGW * 64;
    for (size_t idx = gt; idx < (size_t)T * 384; idx += NT) {
        const int t = (int)(idx / 384), c0 = (int)(idx % 384) * 8;
        float a[8];
        { const f32x4 b0 = *(const f32x4*)(cb + c0), b1 = *(const f32x4*)(cb + c0 + 4);
          a[0] = b0[0]; a[1] = b0[1]; a[2] = b0[2]; a[3] = b0[3]; a[4] = b1[0]; a[5] = b1[1]; a[6] = b1[2]; a[7] = b1[3]; }
#pragma unroll
        for (int jj = 0; jj < 4; ++jj) { const int tt = t - 3 + jj;
            if (tt >= 0) { const u32x4 u = *(const u32x4*)(U + (size_t)tt * EV_INP + UE_XBC + c0);
                const f32x4 w0 = *(const f32x4*)(cw + jj * 3072 + c0), w1 = *(const f32x4*)(cw + jj * 3072 + c0 + 4);
                a[0] += w0[0] * bflo(u.x); a[1] += w0[1] * bfhi(u.x); a[2] += w0[2] * bflo(u.y); a[3] += w0[3] * bfhi(u.y);
                a[4] += w1[0] * bflo(u.z); a[5] += w1[1] * bfhi(u.z); a[6] += w1[2] * bflo(u.w); a[7] += w1[3] * bfhi(u.w); } }
        u32x4 o; o.x = pk2(siluf(a[0]), siluf(a[1])); o.y = pk2(siluf(a[2]), siluf(a[3])); o.z = pk2(siluf(a[4]), siluf(a[5])); o.w = pk2(siluf(a[6]), siluf(a[7]));
        *(u32x4*)(XC + (size_t)t * 3072 + c0) = o;
    }
    float* DT = WSP(float, WS_DT); float* ACS = WSP(float, WS_ACS);
    for (int it = F.gw; it < 64 * 32; it += F.NGW) {
        const int c = it >> 5, h = it & 31, t0 = c * 128 + F.lane, t1 = t0 + 64;
        const float A = -__expf(FIN(7)[j * 32 + h]), dtb = FIN(6)[j * 32 + h];
        const float y0 = bf2f(U[(size_t)t0 * EV_INP + UE_DT + h]) + dtb, y1 = bf2f(U[(size_t)t1 * EV_INP + UE_DT + h]) + dtb;
        const float d0 = y0 > 20.f ? y0 : log1pf(__expf(y0)), d1 = y1 > 20.f ? y1 : log1pf(__expf(y1));
        const float s0 = wave_incl_scan(d0 * A, F.lane); const float tot = __shfl(s0, 63); const float s1 = wave_incl_scan(d1 * A, F.lane) + tot;
        DT[(size_t)t0 * 32 + h] = d0; DT[(size_t)t1 * 32 + h] = d1; ACS[(size_t)t0 * 32 + h] = s0; ACS[(size_t)t1 * 32 + h] = s1;
    }
}

__device__ __forceinline__ void even_conv_item(Frame& F, int j, int c, int g) {
    const bf16* U = WSP(bf16, WS_U); bf16* XC = WSP(bf16, WS_XC);
    const float* cw = FIN(4) + (size_t)j * 4 * 3072; const float* cb = FIN(5) + (size_t)j * 3072;
    if (F.tid < 384) {
        const int tb = F.tid / 96, o8 = F.tid % 96;
        const int c0 = o8 < 64 ? g * 512 + o8 * 8 : (o8 < 80 ? 2048 + g * 128 + (o8 - 64) * 8 : 2560 + g * 128 + (o8 - 80) * 8);
        float wt[4][8], bs[8];
        { const f32x4 b0 = *(const f32x4*)(cb + c0), b1 = *(const f32x4*)(cb + c0 + 4);
          bs[0] = b0[0]; bs[1] = b0[1]; bs[2] = b0[2]; bs[3] = b0[3]; bs[4] = b1[0]; bs[5] = b1[1]; bs[6] = b1[2]; bs[7] = b1[3]; }
#pragma unroll
        for (int jj = 0; jj < 4; ++jj) { const f32x4 w0 = *(const f32x4*)(cw + jj * 3072 + c0), w1 = *(const f32x4*)(cw + jj * 3072 + c0 + 4);
            wt[jj][0] = w0[0]; wt[jj][1] = w0[1]; wt[jj][2] = w0[2]; wt[jj][3] = w0[3]; wt[jj][4] = w1[0]; wt[jj][5] = w1[1]; wt[jj][6] = w1[2]; wt[jj][7] = w1[3]; }
        const int tbase = c * 128 + tb * 32;
        const bf16* up = U + (size_t)tbase * EV_INP + UE_XBC + c0; bf16* xp = XC + (size_t)tbase * 3072 + c0;
        const u32x4 zz = (u32x4){0u, 0u, 0u, 0u};
        u32x4 r0 = tbase >= 3 ? *(const u32x4*)(up - 3 * (ptrdiff_t)EV_INP) : zz, r1 = tbase >= 2 ? *(const u32x4*)(up - 2 * (ptrdiff_t)EV_INP) : zz, r2 = tbase >= 1 ? *(const u32x4*)(up - (ptrdiff_t)EV_INP) : zz;
#define CV_OUT(ra, rb, rc, rd, l_) do { float a_[8]; const u32x4 q_[4] = {ra, rb, rc, rd}; \
            _Pragma("unroll") for (int k_ = 0; k_ < 8; ++k_) a_[k_] = bs[k_]; \
            _Pragma("unroll") for (int jj = 0; jj < 4; ++jj) { a_[0] += wt[jj][0] * bflo(q_[jj].x); a_[1] += wt[jj][1] * bfhi(q_[jj].x); a_[2] += wt[jj][2] * bflo(q_[jj].y); a_[3] += wt[jj][3] * bfhi(q_[jj].y); \
                a_[4] += wt[jj][4] * bflo(q_[jj].z); a_[5] += wt[jj][5] * bfhi(q_[jj].z); a_[6] += wt[jj][6] * bflo(q_[jj].w); a_[7] += wt[jj][7] * bfhi(q_[jj].w); } \
            u32x4 o_; o_.x = pk2(siluf(a_[0]), siluf(a_[1])); o_.y = pk2(siluf(a_[2]), siluf(a_[3])); o_.z = pk2(siluf(a_[4]), siluf(a_[5])); o_.w = pk2(siluf(a_[6]), siluf(a_[7])); \
            *(u32x4*)(xp + (size_t)(l_) * 3072) = o_; } while (0)
#pragma unroll 1
        for (int l4 = 0; l4 < 32; l4 += 4) {
            const u32x4 n0 = *(const u32x4*)(up + (size_t)(l4 + 0) * EV_INP), n1 = *(const u32x4*)(up + (size_t)(l4 + 1) * EV_INP), n2 = *(const u32x4*)(up + (size_t)(l4 + 2) * EV_INP), n3 = *(const u32x4*)(up + (size_t)(l4 + 3) * EV_INP);
            CV_OUT(r0, r1, r2, n0, l4 + 0); CV_OUT(r1, r2, n0, n1, l4 + 1); CV_OUT(r2, n0, n1, n2, l4 + 2); CV_OUT(n0, n1, n2, n3, l4 + 3);
            r0 = n1; r1 = n2; r2 = n3;
        }
#undef CV_OUT
    }
    float* DT = WSP(float, WS_DT); float* ACS = WSP(float, WS_ACS);
    { const int h = g * 8 + F.wave, t0 = c * 128 + F.lane, t1 = t0 + 64;
      const float A = -__expf(FIN(7)[j * 32 + h]), dtb = FIN(6)[j * 32 + h];
      const float y0 = bf2f(U[(size_t)t0 * EV_INP + UE_DT + h]) + dtb, y1 = bf2f(U[(size_t)t1 * EV_INP + UE_DT + h]) + dtb;
      const float d0 = y0 > 20.f ? y0 : log1pf(__expf(y0)), d1 = y1 > 20.f ? y1 : log1pf(__expf(y1));
      const float s0 = wave_incl_scan(d0 * A, F.lane); const float tot = __shfl(s0, 63); const float s1 = wave_incl_scan(d1 * A, F.lane) + tot;
      DT[(size_t)t0 * 32 + h] = d0; DT[(size_t)t1 * 32 + h] = d1; ACS[(size_t)t0 * 32 + h] = s0; ACS[(size_t)t1 * 32 + h] = s1; }
}

__device__ __forceinline__ void even_states(Frame& F, int j) {
    const bf16* XC = WSP(bf16, WS_XC); const float* DT = WSP(float, WS_DT); const float* ACS = WSP(float, WS_ACS); float* ST = WSP(float, WS_STATES);
    constexpr int LD = 136;
    LAS bf16* BT = (LAS bf16*)F.lds;
    LAS bf16* XT = (LAS bf16*)(F.lds + 128 * LD * 2);
    const int tid = F.tid, lane = F.lane, w = F.wave, fr = lane & 15, fq = lane >> 4;
    for (int it = F.cid; it < 256; it += F.G) {
        const int c = it >> 2, g = it & 3;
        even_conv_item(F, j, c, g);
        VM_WAIT(); __syncthreads();
        for (int i = tid; i < 128 * 16; i += 512) { const int l = i >> 4, n8 = i & 15;
            const u32x4 v = *(const u32x4*)(XC + (size_t)(c * 128 + l) * 3072 + 2048 + g * 128 + n8 * 8);
            LAS bf16* d = BT + (n8 * 8) * LD + l;
            d[0 * LD] = (bf16)(v.x & 0xffff); d[1 * LD] = (bf16)(v.x >> 16); d[2 * LD] = (bf16)(v.y & 0xffff); d[3 * LD] = (bf16)(v.y >> 16);
            d[4 * LD] = (bf16)(v.z & 0xffff); d[5 * LD] = (bf16)(v.z >> 16); d[6 * LD] = (bf16)(v.w & 0xffff); d[7 * LD] = (bf16)(v.w >> 16); }
#pragma unroll 1
        for (int r = 0; r < 8; ++r) {
            const int h = g * 8 + r;
            __syncthreads();
            const float aend = ACS[(size_t)(c * 128 + 127) * 32 + h];
            for (int i = tid; i < 128 * 8; i += 512) { const int l = i >> 3, p8 = i & 7; const size_t t = (size_t)c * 128 + l;
                const float wgt = DT[t * 32 + h] * __expf(aend - ACS[t * 32 + h]);
                const u32x4 v = *(const u32x4*)(XC + t * 3072 + h * 64 + p8 * 8);
                LAS bf16* d = XT + (p8 * 8) * LD + l;
                d[0 * LD] = (bf16)f2bf(bflo(v.x) * wgt); d[1 * LD] = (bf16)f2bf(bfhi(v.x) * wgt); d[2 * LD] = (bf16)f2bf(bflo(v.y) * wgt); d[3 * LD] = (bf16)f2bf(bfhi(v.y) * wgt);
                d[4 * LD] = (bf16)f2bf(bflo(v.z) * wgt); d[5 * LD] = (bf16)f2bf(bfhi(v.z) * wgt); d[6 * LD] = (bf16)f2bf(bflo(v.w) * wgt); d[7 * LD] = (bf16)f2bf(bfhi(v.w) * wgt); }
            __syncthreads();
            const int pt = w & 3, nt0 = (w >> 2) * 4;
            f32x4 acc[4];
#pragma unroll
            for (int q = 0; q < 4; ++q) acc[q] = (f32x4){0.f, 0.f, 0.f, 0.f};
#pragma unroll
            for (int ks = 0; ks < 4; ++ks) { const bf16x8 a = *(const LAS bf16x8*)(XT + (16 * pt + fr) * LD + 32 * ks + 8 * fq);
#pragma unroll
                for (int q = 0; q < 4; ++q) { const bf16x8 b = *(const LAS bf16x8*)(BT + (16 * (nt0 + q) + fr) * LD + 32 * ks + 8 * fq); acc[q] = mma16(b, a, acc[q]); } }
            float* sp = ST + ((size_t)(c * 32 + h) * 64 + 16 * pt + fr) * 128 + 4 * fq;
#pragma unroll
            for (int q = 0; q < 4; ++q) *(f32x4*)(sp + 16 * (nt0 + q)) = acc[q];
        }
    }
}

__device__ __forceinline__ u32x4 rope8(const u32x4 own, const f32x4 c0, const f32x4 c1, const f32x4 s0, const f32x4 s1, const float sgn, const float scale) {
    u32x4 pt; pt.x = (unsigned)__shfl_xor((int)own.x, 4); pt.y = (unsigned)__shfl_xor((int)own.y, 4); pt.z = (unsigned)__shfl_xor((int)own.z, 4); pt.w = (unsigned)__shfl_xor((int)own.w, 4);
    const float o[8] = {bflo(own.x), bfhi(own.x), bflo(own.y), bfhi(own.y), bflo(own.z), bfhi(own.z), bflo(own.w), bfhi(own.w)};
    const float q[8] = {bflo(pt.x), bfhi(pt.x), bflo(pt.y), bfhi(pt.y), bflo(pt.z), bfhi(pt.z), bflo(pt.w), bfhi(pt.w)};
    const float cc[8] = {c0[0], c0[1], c0[2], c0[3], c1[0], c1[1], c1[2], c1[3]}, ss[8] = {s0[0], s0[1], s0[2], s0[3], s1[0], s1[1], s1[2], s1[3]};
    float r[8];
#pragma unroll
    for (int e = 0; e < 8; ++e) r[e] = (o[e] * cc[e] + sgn * (q[e] * ss[e])) * scale;
    return (u32x4){pk2(r[0], r[1]), pk2(r[2], r[3]), pk2(r[4], r[5]), pk2(r[6], r[7])};
}
__device__ __forceinline__ void even_swa(Frame& F, int j) {
    const bf16* U = WSP(bf16, WS_U); bf16* YM = WSP(bf16, WS_YMIX); const float* COS = WSP(float, WS_COS); const float* SIN = WSP(float, WS_SIN);
    constexpr int LK = 72, LV = 216, LP = 168;
    LAS bf16* KS = (LAS bf16*)F.lds;
    LAS bf16* VT = (LAS bf16*)(F.lds + 192 * LK * 2);
    LAS bf16* PW = (LAS bf16*)(F.lds + 192 * LK * 2 + 64 * LV * 2) + F.wave * 16 * LP;
    const int tid = F.tid, lane = F.lane, w = F.wave, fr = lane & 15, fq = lane >> 4;
    for (int it = F.cid; it < 256; it += F.G) {
        const int qb = it >> 1, kvh = it & 1, ws0 = qb * 64 - 128;
        __syncthreads();
        for (int i = tid; i < 192 * 4; i += 512) { const int kw = i >> 2, d8 = i & 3, ka = ws0 + kw;
            u32x4 o1 = (u32x4){0u, 0u, 0u, 0u}, o2 = o1;
            if (ka >= 0) { const bf16* kp = U + (size_t)ka * EV_INP + UE_K + kvh * 64 + d8 * 8;
                const u32x4 v1 = *(const u32x4*)kp, v2 = *(const u32x4*)(kp + 32);
                const f32x4 c0 = *(const f32x4*)(COS + (size_t)ka * 32 + d8 * 8), c1 = *(const f32x4*)(COS + (size_t)ka * 32 + d8 * 8 + 4);
                const f32x4 s0 = *(const f32x4*)(SIN + (size_t)ka * 32 + d8 * 8), s1 = *(const f32x4*)(SIN + (size_t)ka * 32 + d8 * 8 + 4);
                const float t1[8] = {bflo(v1.x), bfhi(v1.x), bflo(v1.y), bfhi(v1.y), bflo(v1.z), bfhi(v1.z), bflo(v1.w), bfhi(v1.w)};
                const float t2[8] = {bflo(v2.x), bfhi(v2.x), bflo(v2.y), bfhi(v2.y), bflo(v2.z), bfhi(v2.z), bflo(v2.w), bfhi(v2.w)};
                const float cc[8] = {c0[0], c0[1], c0[2], c0[3], c1[0], c1[1], c1[2], c1[3]}, ss[8] = {s0[0], s0[1], s0[2], s0[3], s1[0], s1[1], s1[2], s1[3]};
                float r1[8], r2[8];
#pragma unroll
                for (int k = 0; k < 8; ++k) { r1[k] = t1[k] * cc[k] - t2[k] * ss[k]; r2[k] = t2[k] * cc[k] + t1[k] * ss[k]; }
                o1 = (u32x4){pk2(r1[0], r1[1]), pk2(r1[2], r1[3]), pk2(r1[4], r1[5]), pk2(r1[6], r1[7])};
                o2 = (u32x4){pk2(r2[0], r2[1]), pk2(r2[2], r2[3]), pk2(r2[4], r2[5]), pk2(r2[6], r2[7])}; }
            *(LAS u32x4*)(KS + kw * LK + d8 * 8) = o1; *(LAS u32x4*)(KS + kw * LK + 32 + d8 * 8) = o2; }
        for (int i = tid; i < 208 * 8; i += 512) { const int kw = i >> 3, d8 = i & 7, ka = ws0 + kw;
            u32x4 v = (u32x4){0u, 0u, 0u, 0u};
            if (kw < 192 && ka >= 0) v = *(const u32x4*)(U + (size_t)ka * EV_INP + UE_V + kvh * 64 + d8 * 8);
            LAS bf16* d = VT + (d8 * 8) * LV + kw;
            d[0 * LV] = (bf16)(v.x & 0xffff); d[1 * LV] = (bf16)(v.x >> 16); d[2 * LV] = (bf16)(v.y & 0xffff); d[3 * LV] = (bf16)(v.y >> 16);
            d[4 * LV] = (bf16)(v.z & 0xffff); d[5 * LV] = (bf16)(v.z >> 16); d[6 * LV] = (bf16)(v.w & 0xffff); d[7 * LV] = (bf16)(v.w >> 16); }
        __syncthreads();
        const int hq = kvh * 8 + w;
        const float sink2 = FIN(10)[j * 16 + hq] * LOG2E;
#pragma unroll 1
        for (int hf = 0; hf < 2; ++hf) {
          bf16x8 qa[2][2];
          { LAS unsigned char* qs = (LAS unsigned char*)PW;
#pragma unroll
            for (int k = 0; k < 4; ++k) { const int row = 8 * k + (lane >> 3), c = lane & 7, tq = qb * 64 + 32 * hf + row;
                const u32x4 own = *(const u32x4*)(U + (size_t)tq * EV_INP + UE_Q + hq * 64 + c * 8);
                const float* cp = COS + (size_t)tq * 32 + (c & 3) * 8; const float* sp = SIN + (size_t)tq * 32 + (c & 3) * 8;
                const u32x4 rq = rope8(own, *(const f32x4*)cp, *(const f32x4*)(cp + 4), *(const f32x4*)sp, *(const f32x4*)(sp + 4), (c & 4) ? 1.f : -1.f, SWA_QSCALE);
                *(LAS u32x4*)(qs + row * 144 + c * 16) = rq; }
#pragma unroll
            for (int q2 = 0; q2 < 2; ++q2) { qa[q2][0] = *(const LAS bf16x8*)(qs + (16 * q2 + fr) * 144 + fq * 16); qa[q2][1] = *(const LAS bf16x8*)(qs + (16 * q2 + fr) * 144 + 64 + fq * 16); }
            LDS_WAIT(); }
#pragma unroll
          for (int q2 = 0; q2 < 2; ++q2) {
            const int qt = 2 * hf + q2;
            const bf16x8 a0 = qa[q2][0], a1 = qa[q2][1];
            f32x4 s[9];
#pragma unroll
            for (int kk = 0; kk < 9; ++kk) { const int kt = qt + kk;
                const bf16x8 b0 = *(const LAS bf16x8*)(KS + (16 * kt + fr) * LK + 8 * fq), b1 = *(const LAS bf16x8*)(KS + (16 * kt + fr) * LK + 32 + 8 * fq);
                f32x4 z = (f32x4){0.f, 0.f, 0.f, 0.f}; z = mma16(a0, b0, z); s[kk] = mma16(a1, b1, z); }
            float mx[4], sm[4];
#pragma unroll
            for (int i = 0; i < 4; ++i) { const int tq = qb * 64 + 16 * qt + 4 * fq + i; float m = -INFINITY;
#pragma unroll
                for (int kk = 0; kk < 9; ++kk) { const int ka = ws0 + 16 * (qt + kk) + fr; const bool ok = (ka >= 0) && (ka <= tq) && (tq - ka < 128);
                    s[kk][i] = ok ? s[kk][i] : -INFINITY; m = fmaxf(m, s[kk][i]); }
                m = fmaxf(grp16_max(m), sink2); mx[i] = m; float e = 0.f;
#pragma unroll
                for (int kk = 0; kk < 9; ++kk) { const float p = exp2f(s[kk][i] - m); s[kk][i] = p; e += p; }
                sm[i] = 1.f / (grp16_sum(e) + exp2f(sink2 - m)); }
#pragma unroll
            for (int i = 0; i < 4; ++i) {
#pragma unroll
                for (int kk = 0; kk < 9; ++kk) PW[(4 * fq + i) * LP + 16 * kk + fr] = (bf16)f2bf(s[kk][i] * sm[i]);
                PW[(4 * fq + i) * LP + 144 + fr] = (bf16)0; }
            LDS_WAIT();
            f32x4 o[4];
#pragma unroll
            for (int dt = 0; dt < 4; ++dt) o[dt] = (f32x4){0.f, 0.f, 0.f, 0.f};
#pragma unroll
            for (int ks = 0; ks < 5; ++ks) { const bf16x8 a = *(const LAS bf16x8*)(PW + fr * LP + 32 * ks + 8 * fq);
#pragma unroll
                for (int dt = 0; dt < 4; ++dt) { const bf16x8 b = *(const LAS bf16x8*)(VT + (16 * dt + fr) * LV + 16 * qt + 32 * ks + 8 * fq); o[dt] = mma16(a, b, o[dt]); } }
            LDS_WAIT();
#pragma unroll
            for (int i = 0; i < 4; ++i)
#pragma unroll
                for (int dt = 0; dt < 4; ++dt) PW[(4 * fq + i) * 72 + 16 * dt + fr] = (bf16)f2bf(o[dt][i]);
#pragma unroll
            for (int k = 0; k < 2; ++k) { const int row = 8 * k + (lane >> 3), c8 = lane & 7;
                const u32x4 ov = *(const LAS u32x4*)((LAS unsigned char*)PW + row * 144 + c8 * 16);
                *(u32x4*)(YM + (size_t)(qb * 64 + 16 * qt + row) * 3072 + 2048 + hq * 64 + c8 * 8) = ov; }
            LDS_WAIT();
          }
        }
    }
}

__device__ __forceinline__ void even_scan(Frame& F) {
    const f32x4* ST = WSP(f32x4, WS_STATES); u32x2* PV = WSP(u32x2, WS_PREVB); const float* ACS = WSP(float, WS_ACS);
    if (F.wave >= 4) return;
    const size_t gt = (size_t)(F.cid * 4 + F.wave) * 64 + F.lane, NT = (size_t)F.G * 4 * 64;
    for (size_t e4 = gt; e4 < 65536; e4 += NT) {
        const int h = (int)(e4 >> 11); f32x4 hs = (f32x4){0.f, 0.f, 0.f, 0.f};
#pragma unroll 8
        for (int c = 0; c < 64; ++c) { const float dec = __expf(ACS[(size_t)(c * 128 + 127) * 32 + h]); const f32x4 st = ST[(size_t)c * 65536 + e4];
            PV[(size_t)c * 65536 + e4] = (u32x2){pk2(hs[0], hs[1]), pk2(hs[2], hs[3])}; hs = hs * dec + st; }
    }
}

__device__ __forceinline__ void even_y(Frame& F, int j) {
    const bf16* XC = WSP(bf16, WS_XC); const bf16* U = WSP(bf16, WS_U); const float* DT = WSP(float, WS_DT); const float* ACS = WSP(float, WS_ACS);
    const bf16* PV = WSP(bf16, WS_PREVB); bf16* YM = WSP(bf16, WS_YMIX); float* YF = WSP(float, WS_H);
    constexpr int LD = 136;
    LAS bf16* CS = (LAS bf16*)F.lds;
    LAS bf16* BS = (LAS bf16*)(F.lds + 34816);
    LAS bf16* XT = (LAS bf16*)(F.lds + 69632);
    LAS bf16* MW = (LAS bf16*)(F.lds + 87040) + F.wave * 16 * LD;
    LAS float* AL = (LAS float*)(F.lds + 121856);
    LAS float* DL = (LAS float*)(F.lds + 125952);
    LAS bf16* PS = (LAS bf16*)(F.lds + 130048);
    const int tid = F.tid, lane = F.lane, w = F.wave, fr = lane & 15, fq = lane >> 4;
    for (int it = F.cid; it < 256; it += F.G) {
        const int c = it >> 2, g = it & 3;
        u32x4 xr0, xr1, pr0, pr1;
#define Y_FETCH(r_) do { const int h_ = g * 8 + (r_); const bf16* pv_ = PV + (size_t)(c * 32 + h_) * 64 * 128; \
            xr0 = *(const u32x4*)(XC + (size_t)(c * 128 + (tid >> 3)) * 3072 + h_ * 64 + (tid & 7) * 8); xr1 = *(const u32x4*)(XC + (size_t)(c * 128 + 64 + (tid >> 3)) * 3072 + h_ * 64 + (tid & 7) * 8); \
            pr0 = *(const u32x4*)(pv_ + (size_t)(tid >> 4) * 128 + (tid & 15) * 8); pr1 = *(const u32x4*)(pv_ + (size_t)(32 + (tid >> 4)) * 128 + (tid & 15) * 8); } while (0)
        Y_FETCH(0);
        __syncthreads();
        for (int i = tid; i < 128 * 16; i += 512) { const int l = i >> 4, n8 = i & 15; const bf16* src = XC + (size_t)(c * 128 + l) * 3072 + g * 128 + n8 * 8;
            *(LAS u32x4*)(BS + l * LD + n8 * 8) = *(const u32x4*)(src + 2048); *(LAS u32x4*)(CS + l * LD + n8 * 8) = *(const u32x4*)(src + 2560); }
        for (int i = tid; i < 128 * 8; i += 512) { const int l = i >> 3, r = i & 7; AL[i] = ACS[(size_t)(c * 128 + l) * 32 + g * 8 + r]; DL[i] = DT[(size_t)(c * 128 + l) * 32 + g * 8 + r]; }
        __syncthreads();
        f32x4 cb[8];
#pragma unroll
        for (int st = 0; st < 8; ++st) cb[st] = (f32x4){0.f, 0.f, 0.f, 0.f};
#pragma unroll
        for (int ks = 0; ks < 4; ++ks) { const bf16x8 a = *(const LAS bf16x8*)(CS + (16 * w + fr) * LD + 32 * ks + 8 * fq);
#pragma unroll
            for (int st = 0; st < 8; ++st) { const bf16x8 b = *(const LAS bf16x8*)(BS + (16 * st + fr) * LD + 32 * ks + 8 * fq); cb[st] = mma16(a, b, cb[st]); } }
        float ssq[4] = {0.f, 0.f, 0.f, 0.f};
#pragma unroll 1
        for (int r = 0; r < 8; ++r) {
            const int h = g * 8 + r;
            __syncthreads();
#pragma unroll
            for (int k = 0; k < 2; ++k) { const int s = 64 * k + (tid >> 3), p8 = tid & 7; const float wgt = DL[s * 8 + r]; const u32x4 v = k ? xr1 : xr0;
                LAS bf16* d = XT + (p8 * 8) * LD + s;
                d[0 * LD] = (bf16)f2bf(bflo(v.x) * wgt); d[1 * LD] = (bf16)f2bf(bfhi(v.x) * wgt); d[2 * LD] = (bf16)f2bf(bflo(v.y) * wgt); d[3 * LD] = (bf16)f2bf(bfhi(v.y) * wgt);
                d[4 * LD] = (bf16)f2bf(bflo(v.z) * wgt); d[5 * LD] = (bf16)f2bf(bfhi(v.z) * wgt); d[6 * LD] = (bf16)f2bf(bflo(v.w) * wgt); d[7 * LD] = (bf16)f2bf(bfhi(v.w) * wgt); }
            *(LAS u32x4*)(PS + (tid >> 4) * LD + (tid & 15) * 8) = pr0; *(LAS u32x4*)(PS + (32 + (tid >> 4)) * LD + (tid & 15) * 8) = pr1;
            __syncthreads();
            if (r < 7) Y_FETCH(r + 1);
            f32x4 acc[4];
#pragma unroll
            for (int pt = 0; pt < 4; ++pt) acc[pt] = (f32x4){0.f, 0.f, 0.f, 0.f};
#pragma unroll
            for (int ks = 0; ks < 4; ++ks) { const bf16x8 a = *(const LAS bf16x8*)(CS + (16 * w + fr) * LD + 32 * ks + 8 * fq);
#pragma unroll
                for (int pt = 0; pt < 4; ++pt) { const bf16x8 b = *(const LAS bf16x8*)(PS + (16 * pt + fr) * LD + 32 * ks + 8 * fq); acc[pt] = mma16(a, b, acc[pt]); } }
            float al[4];
#pragma unroll
            for (int i = 0; i < 4; ++i) { al[i] = AL[(16 * w + 4 * fq + i) * 8 + r]; const float e = __expf(al[i]);
#pragma unroll
                for (int pt = 0; pt < 4; ++pt) acc[pt][i] *= e; }
#pragma unroll
            for (int st = 0; st < 8; ++st) { const int s = 16 * st + fr; const float as = AL[s * 8 + r];
#pragma unroll
                for (int i = 0; i < 4; ++i) { const int l = 16 * w + 4 * fq + i; const float mv = (s <= l) ? cb[st][i] * __expf(al[i] - as) : 0.f;
                    MW[(4 * fq + i) * LD + s] = (bf16)f2bf(mv); } }
            LDS_WAIT();
#pragma unroll
            for (int ks = 0; ks < 4; ++ks) { const bf16x8 a = *(const LAS bf16x8*)(MW + fr * LD + 32 * ks + 8 * fq);
#pragma unroll
                for (int pt = 0; pt < 4; ++pt) { const bf16x8 b = *(const LAS bf16x8*)(XT + (16 * pt + fr) * LD + 32 * ks + 8 * fq); acc[pt] = mma16(a, b, acc[pt]); } }
            LDS_WAIT();
            const float dsk = FIN(8)[j * 32 + h];
#pragma unroll
            for (int i = 0; i < 4; ++i) { const size_t t = (size_t)c * 128 + 16 * w + 4 * fq + i;
#pragma unroll
                for (int pt = 0; pt < 4; ++pt) { const int col = h * 64 + 16 * pt + fr;
                    const float xv = bf2f(XC[t * 3072 + col]), zv = bf2f(U[t * EV_INP + UE_Z + col]);
                    const float yy = (acc[pt][i] + xv * dsk) * siluf(zv); ssq[i] += yy * yy; YF[t * D + col] = yy; } }
        }
        VM_WAIT();
        const float* nw = FIN(9) + (size_t)j * 2048 + g * 512;
        const f32x4 nw0 = *(const f32x4*)(nw + lane * 4), nw1 = *(const f32x4*)(nw + 256 + lane * 4);
        float rs[4];
#pragma unroll
        for (int i = 0; i < 4; ++i) rs[i] = rsqrtf(grp16_sum(ssq[i]) * (1.f / 512.f) + LN_EPS);
#pragma unroll
        for (int rr = 0; rr < 16; ++rr) {
            const float rstd = __shfl(rs[rr & 3], 16 * (rr >> 2));
            const size_t t = (size_t)c * 128 + 16 * w + rr;
            const f32x4 y0 = *(const f32x4*)(YF + t * D + g * 512 + lane * 4), y1 = *(const f32x4*)(YF + t * D + g * 512 + 256 + lane * 4);
            u32x2 o0, o1; o0.x = pk2(y0[0] * rstd * nw0[0], y0[1] * rstd * nw0[1]); o0.y = pk2(y0[2] * rstd * nw0[2], y0[3] * rstd * nw0[3]);
            o1.x = pk2(y1[0] * rstd * nw1[0], y1[1] * rstd * nw1[1]); o1.y = pk2(y1[2] * rstd * nw1[2], y1[3] * rstd * nw1[3]);
            *(u32x2*)(YM + t * 3072 + g * 512 + lane * 4) = o0; *(u32x2*)(YM + t * 3072 + g * 512 + 256 + lane * 4) = o1; }
    }
#undef Y_FETCH
}

struct PrepRaw { u32x4 ckv, qi[2], qr[2], kk; f32x4 c0, c1, s0, s1; unsigned wi; };
__device__ __forceinline__ void prep_load(const bf16* U, const float* COS, const float* SIN, const int t, const int lane, PrepRaw& R) {
    const bf16* u = U + (size_t)t * OD_INP;
    R.ckv = *(const u32x4*)(u + UO_CKV + lane * 8);
    const float* cp = COS + (size_t)t * 32 + (lane & 3) * 8; const float* sp = SIN + (size_t)t * 32 + (lane & 3) * 8;
    R.c0 = *(const f32x4*)cp; R.c1 = *(const f32x4*)(cp + 4); R.s0 = *(const f32x4*)sp; R.s1 = *(const f32x4*)(sp + 4);
    R.kk = *(const u32x4*)(u + UO_KR + (lane & 15) * 8);
    R.wi = u[UO_WI + (lane & 15)];
#pragma unroll
    for (int k = 0; k < 2; ++k) { const int c = lane + 64 * k, h = c >> 3, ch = c & 7;
        R.qi[k] = *(const u32x4*)(u + UO_QI + c * 8); R.qr[k] = *(const u32x4*)(u + UO_Q + h * 192 + 128 + ch * 8); }
}
__device__ __forceinline__ u32x4 rope_chunk(const u32x4 own, const PrepRaw& R, const float sgn, const float scale) {
    u32x4 pt; pt.x = (unsigned)__shfl_xor((int)own.x, 4); pt.y = (unsigned)__shfl_xor((int)own.y, 4); pt.z = (unsigned)__shfl_xor((int)own.z, 4); pt.w = (unsigned)__shfl_xor((int)own.w, 4);
    const float o[8] = {bflo(own.x), bfhi(own.x), bflo(own.y), bfhi(own.y), bflo(own.z), bfhi(own.z), bflo(own.w), bfhi(own.w)};
    const float q[8] = {bflo(pt.x), bfhi(pt.x), bflo(pt.y), bfhi(pt.y), bflo(pt.z), bfhi(pt.z), bflo(pt.w), bfhi(pt.w)};
    const float cc[8] = {R.c0[0], R.c0[1], R.c0[2], R.c0[3], R.c1[0], R.c1[1], R.c1[2], R.c1[3]}, ss[8] = {R.s0[0], R.s0[1], R.s0[2], R.s0[3], R.s1[0], R.s1[1], R.s1[2], R.s1[3]};
    float r[8];
#pragma unroll
    for (int e = 0; e < 8; ++e) r[e] = (o[e] * cc[e] + sgn * (q[e] * ss[e])) * scale;
    return (u32x4){pk2(r[0], r[1]), pk2(r[2], r[3]), pk2(r[4], r[5]), pk2(r[6], r[7])};
}
__device__ __forceinline__ void prep_finish(bf16* KV, bf16* QI, bf16* KI, float* WI, bf16* QL, const f32x4 g0, const f32x4 g1, const int t, const int lane, const PrepRaw& R) {
    const float sgn = (lane & 4) ? 1.f : -1.f;
    { const u32x4 v = R.ckv;
      float x[8] = {bflo(v.x), bfhi(v.x), bflo(v.y), bfhi(v.y), bflo(v.z), bfhi(v.z), bflo(v.w), bfhi(v.w)}; float ss = 0.f;
#pragma unroll
      for (int k = 0; k < 8; ++k) ss += x[k] * x[k];
      const float rstd = rsqrtf(wave_sum(ss) * (1.f / 512.f) + LN_EPS);
      u32x4 o; o.x = pk2(x[0] * rstd * g0[0], x[1] * rstd * g0[1]); o.y = pk2(x[2] * rstd * g0[2], x[3] * rstd * g0[3]);
      o.z = pk2(x[4] * rstd * g1[0], x[5] * rstd * g1[1]); o.w = pk2(x[6] * rstd * g1[2], x[7] * rstd * g1[3]);
      *(u32x4*)(KV + (size_t)t * 576 + lane * 8) = o; }
    { const u32x4 o = rope_chunk(R.kk, R, sgn, 1.f);
      bf16* dst = (lane & 8) ? KI + (size_t)t * 64 + (lane & 7) * 8 : KV + (size_t)t * 576 + 512 + (lane & 7) * 8;
      if (lane < 16) *(u32x4*)dst = o; }
    if (lane < 16) WI[(size_t)t * 16 + lane] = bf2f((unsigned short)R.wi) * 0.03125f;
#pragma unroll
    for (int k = 0; k < 2; ++k) { const int c = lane + 64 * k, h = c >> 3, ch = c & 7;
        *(u32x4*)(QI + (size_t)t * 1024 + c * 8) = rope_chunk(R.qi[k], R, sgn, 1.f);
        *(u32x4*)(QL + (size_t)t * QLD + h * 576 + 512 + ch * 8) = rope_chunk(R.qr[k], R, sgn, MLA_QSCALE); }
}
__device__ __forceinline__ void odd_prep(Frame& F, int j) {
    const bf16* U = WSP(bf16, WS_U); bf16* KV = WSP(bf16, WS_KV); bf16* QI = WSP(bf16, WS_QI); bf16* KI = WSP(bf16, WS_KI); float* WI = WSP(float, WS_WI); bf16* QL = WSP(bf16, WS_QL);
    const float* COS = WSP(float, WS_COS); const float* SIN = WSP(float, WS_SIN); const float* kvn = FIN(13) + (size_t)j * 512;
    const int lane = F.lane;
    const f32x4 g0 = *(const f32x4*)(kvn + lane * 8), g1 = *(const f32x4*)(kvn + lane * 8 + 4);
    for (int t = F.gw; t < T; t += 2 * F.NGW) {
        const int tb = t + F.NGW;
        int ln = lane; asm volatile("" : "+v"(ln));
        PrepRaw A, B;
        prep_load(U, COS, SIN, t, ln, A);
        prep_load(U, COS, SIN, tb < T ? tb : t, ln, B);
        prep_finish(KV, QI, KI, WI, QL, g0, g1, t, ln, A);
        if (tb < T) prep_finish(KV, QI, KI, WI, QL, g0, g1, tb, ln, B);
    }
}
__device__ __forceinline__ float relu1(float v) { const int b = __builtin_bit_cast(int, v); return __builtin_bit_cast(float, b > 0 ? b : 0); }
__device__ __forceinline__ void sc_unit(const int u, int& qt, int& kt) {
    qt = (int)((sqrtf(8.f * (float)u + 1.f) - 1.f) * 0.5f);
    while (qt * (qt + 1) / 2 > u) --qt;
    while ((qt + 1) * (qt + 2) / 2 <= u) ++qt;
    kt = u - qt * (qt + 1) / 2;
}
__device__ __forceinline__ void odd_scores(Frame& F) {
    const bf16* QI = WSP(bf16, WS_QI); const bf16* KI = WSP(bf16, WS_KI); const float* WI = WSP(float, WS_WI); float* S = WSP(float, WS_S);
    const int lane = F.lane, w = F.wave, fr = lane & 15, fq = lane >> 4;
    int u = F.cid; if (u >= 2080) return;
    LAS unsigned char* qb = F.lds + w * 8192;
    LAS unsigned char* kb = F.lds + 65536;
    const int o0 = fr * 128 + ((fq ^ ((fr >> 1) & 7)) * 16);
    const int lr = lane >> 3, lp = lane & 7;
    const int c0 = lp ^ (lr >> 1), c1 = lp ^ (4 + (lr >> 1));
    int qt, kt; sc_unit(u, qt, kt);
    {
        const bf16* kp = KI + (size_t)(kt * 128 + 16 * w + lr) * 64;
        const u32x4 k0 = *(const u32x4*)(kp + c0 * 8), k1 = *(const u32x4*)(kp + 8 * 64 + c1 * 8);
        *(LAS u32x4*)(kb + (16 * w) * 128 + lane * 16) = k0; *(LAS u32x4*)(kb + (16 * w + 8) * 128 + lane * 16) = k1;
    }
    const bf16* qa0 = QI + (size_t)(qt * 128 + 16 * w + lr) * 1024 + c0 * 8;
    const bf16* qa1 = QI + (size_t)(qt * 128 + 16 * w + 8 + lr) * 1024 + c1 * 8;
#define SC_DMA(buf, h0, p0, p1) do { _Pragma("unroll") for (int q_ = 0; q_ < 2; ++q_) { \
        __builtin_amdgcn_global_load_lds((const unsigned*)((p0) + ((h0) + q_) * 64), (LAS unsigned*)(qb + (buf) * 4096 + q_ * 2048), 16, 0, 0); \
        __builtin_amdgcn_global_load_lds((const unsigned*)((p1) + ((h0) + q_) * 64), (LAS unsigned*)(qb + (buf) * 4096 + q_ * 2048 + 1024), 16, 0, 0); } } while (0)
#define SC_FRAG(buf) do { _Pragma("unroll") for (int q_ = 0; q_ < 2; ++q_) { af[buf][q_][0] = *(LAS bf16x8*)(qb + (buf) * 4096 + q_ * 2048 + o0); af[buf][q_][1] = *(LAS bf16x8*)(qb + (buf) * 4096 + q_ * 2048 + (o0 ^ 64)); } } while (0)
    SC_DMA(0, 0, qa0, qa1); SC_DMA(1, 2, qa0, qa1);
    f32x4 wv[4], wn[4]; u32x4 kn0, kn1;
#pragma unroll
    for (int i = 0; i < 4; ++i) wv[i] = *(const f32x4*)(WI + (size_t)(qt * 128 + 16 * w + fr) * 16 + 4 * i);
    VM_WAIT(); LDS_WAIT(); __syncthreads();
    bf16x8 kf[8][2], af[2][2][2];
#pragma unroll
    for (int st = 0; st < 8; ++st) { kf[st][0] = *(LAS bf16x8*)(kb + st * 2048 + o0); kf[st][1] = *(LAS bf16x8*)(kb + st * 2048 + (o0 ^ 64)); }
    SC_FRAG(0);
    int par = 0;
#pragma unroll 1
    while (true) {
        const int un = u + F.G; const bool more = un < 2080; int qtn = qt, ktn = kt; if (more) sc_unit(un, qtn, ktn);
        const bf16* qn0 = QI + (size_t)(qtn * 128 + 16 * w + lr) * 1024 + c0 * 8;
        const bf16* qn1 = QI + (size_t)(qtn * 128 + 16 * w + 8 + lr) * 1024 + c1 * 8;
        f32x4 sc[8];
#pragma unroll
        for (int st = 0; st < 8; ++st) sc[st] = (f32x4){0.f, 0.f, 0.f, 0.f};
#pragma unroll
        for (int hg = 0; hg < 8; ++hg) {
            if (hg == 0) asm volatile("s_waitcnt vmcnt(8)" ::: "memory"); else asm volatile("s_waitcnt vmcnt(0)" ::: "memory");
            SC_FRAG((hg + 1) & 1);
            LDS_WAIT();
            if (hg < 6) SC_DMA(hg & 1, 2 * (hg + 2), qa0, qa1); else SC_DMA(hg & 1, 2 * (hg - 6), qn0, qn1);
            if (hg == 2) {
                const bf16* kp = KI + (size_t)(ktn * 128 + 16 * w + lr) * 64;
                kn0 = *(const u32x4*)(kp + c0 * 8); kn1 = *(const u32x4*)(kp + 8 * 64 + c1 * 8);
#pragma unroll
                for (int i = 0; i < 4; ++i) wn[i] = *(const f32x4*)(WI + (size_t)(qtn * 128 + 16 * w + fr) * 16 + 4 * i);
            }
            __builtin_amdgcn_sched_barrier(0);
            f32x4 zc, zn;
#define SC_MMA(zv, s_) do { zv = (f32x4){0.f, 0.f, 0.f, 0.f}; zv = mma16(kf[(s_) & 7][0], af[hg & 1][(s_) >> 3][0], zv); zv = mma16(kf[(s_) & 7][1], af[hg & 1][(s_) >> 3][1], zv); } while (0)
            SC_MMA(zc, 0);
#pragma unroll
            for (int s_i = 0; s_i < 16; ++s_i) {
                if (s_i < 15) SC_MMA(zn, s_i + 1);
                const float wq = wv[hg >> 1][2 * (hg & 1) + (s_i >> 3)]; const int st = s_i & 7;
                sc[st][0] += wq * relu1(zc[0]); sc[st][1] += wq * relu1(zc[1]); sc[st][2] += wq * relu1(zc[2]); sc[st][3] += wq * relu1(zc[3]);
                asm volatile("" : "+v"(sc[st]));
                zc = zn;
                __builtin_amdgcn_sched_barrier(0);
            }
#undef SC_MMA
            __builtin_amdgcn_sched_barrier(0);
        }
        if (more) {
            LAS unsigned char* kbn = kb + (par ^ 1) * 16384;
            *(LAS u32x4*)(kbn + (16 * w) * 128 + lane * 16) = kn0; *(LAS u32x4*)(kbn + (16 * w + 8) * 128 + lane * 16) = kn1;
            LDS_WAIT(); __builtin_amdgcn_s_barrier();
#pragma unroll
            for (int st = 0; st < 8; ++st) { kf[st][0] = *(LAS bf16x8*)(kbn + st * 2048 + o0); kf[st][1] = *(LAS bf16x8*)(kbn + st * 2048 + (o0 ^ 64)); }
        }
        float* sp = S + (size_t)(qt * 128 + 16 * w + fr) * T + kt * 128 + 4 * fq;
#pragma unroll
        for (int st = 0; st < 8; ++st) *(f32x4*)(sp + 16 * st) = sc[st];
        if (!more) break;
#pragma unroll
        for (int i = 0; i < 4; ++i) wv[i] = wn[i];
        par ^= 1; u = un; qt = qtn; kt = ktn; qa0 = qn0; qa1 = qn1;
    }
    VM_WAIT();
#undef SC_DMA
#undef SC_FRAG
}

__device__ __forceinline__ unsigned f2key(float v) { const unsigned u = __builtin_bit_cast(unsigned, v); return (u & 0x80000000u) ? ~u : (u | 0x80000000u); }
__device__ __forceinline__ unsigned wave_min_u32(unsigned v) {
#pragma unroll
    for (int o = 1; o < 64; o <<= 1) { const unsigned t = (unsigned)__shfl_xor((int)v, o); v = t < v ? t : v; }
    return v;
}
__device__ __forceinline__ unsigned wave_max_u32(unsigned v) {
#pragma unroll
    for (int o = 1; o < 64; o <<= 1) { const unsigned t = (unsigned)__shfl_xor((int)v, o); v = t > v ? t : v; }
    return v;
}
__device__ __forceinline__ void odd_topk(Frame& F, const int probe_stop = 0) {
    const float* S = WSP(float, WS_S); int* SEL = WSP(int, WS_SEL);
    constexpr int CCAP = 1920;
    LAS unsigned long long* cand = (LAS unsigned long long*)(F.lds + F.wave * 16384);
    LAS unsigned* bm = (LAS unsigned*)(F.lds + F.wave * 16384 + CCAP * 8);
    const int lane = F.lane; const unsigned long long lt = (1ull << lane) - 1ull;
    for (int t = F.gw; t < T; t += F.NGW) {
        const int n = t + 1; int* sel = SEL + (size_t)t * 256;
        if (n <= 256) { for (int i = lane; i < 256; i += 64) sel[i] = i < n ? i : 0; continue; }
        const float* row = S + (size_t)t * T; const int nch = (n + 63) >> 6; const int nit = (n + 1023) >> 10;
        unsigned a = 0u, b = 0u, c = 0u, d = 0u;
#define TK_INS(kk) do { const unsigned k_ = (kk); const unsigned t0 = k_ < a ? k_ : a; a = k_ < a ? a : k_; const unsigned t1 = t0 < b ? t0 : b; b = t0 < b ? b : t0; \
            const unsigned t2 = t1 < c ? t1 : c; c = t1 < c ? c : t1; d = t2 < d ? d : t2; } while (0)
#pragma unroll 1
        for (int it = 0; it < nit; ++it) {
            f32x4 v[4];
#pragma unroll
            for (int u = 0; u < 4; ++u) v[u] = *(const f32x4*)(row + it * 1024 + u * 256 + lane * 4);
#pragma unroll
            for (int u = 0; u < 4; ++u)
#pragma unroll
                for (int e = 0; e < 4; ++e) { const int s = it * 1024 + u * 256 + lane * 4 + e; TK_INS(s < n ? f2key(v[u][e]) : 0u); } }
#undef TK_INS
        const unsigned L = wave_min_u32(d);
        const unsigned kmax = wave_max_u32(a); const unsigned xd = L ^ kmax; const int sb = xd ? 31 - __builtin_clz(xd) : -1;
        const unsigned thr0 = sb < 0 ? L : (sb == 31 ? 0u : (L & ~((2u << sb) - 1u)));
        if (probe_stop == 1) { if (L == 0xFFFFFFFFu) sel[0] = 0; continue; }
        unsigned cnt = 0u;
#pragma unroll 1
        for (int it = 0; it < nit; ++it) {
            f32x4 v[4];
#pragma unroll
            for (int u = 0; u < 4; ++u) v[u] = *(const f32x4*)(row + it * 1024 + u * 256 + lane * 4);
#pragma unroll
            for (int u = 0; u < 4; ++u)
#pragma unroll
                for (int e = 0; e < 4; ++e) { const int s = it * 1024 + u * 256 + lane * 4 + e; const unsigned k = s < n ? f2key(v[u][e]) : 0u;
                    const bool pred = (s < n) && (k >= L); const unsigned long long mk = __ballot(pred);
                    if (pred) { const unsigned pos = cnt + (unsigned)__popcll(mk & lt); if (pos < (unsigned)CCAP) cand[pos] = ((unsigned long long)k << 32) | (unsigned)s; }
                    cnt += (unsigned)__popcll(mk); } }
        LDS_WAIT();
        if (probe_stop == 2) continue;
        unsigned thr = thr0;
        *(LAS u32x4*)(bm + 4 * lane) = (u32x4){0u, 0u, 0u, 0u};
        if (cnt <= (unsigned)CCAP) {
            const int ns = (int)((cnt + 63u) >> 6);
            if (cnt <= 512u) {
                unsigned ck[8];
#pragma unroll
                for (int jj = 0; jj < 8; ++jj) { const unsigned idx = jj * 64 + lane; ck[jj] = idx < cnt ? (unsigned)(cand[idx] >> 32) : 0u; }
#pragma unroll 1
                for (int bit = sb; bit >= 0; --bit) { const unsigned trial = thr | (1u << bit); unsigned c2 = 0u;
#pragma unroll
                    for (int jj = 0; jj < 8; ++jj) c2 += (unsigned)__popcll(__ballot(ck[jj] >= trial));
                    if (c2 >= 256u) thr = trial; }
            } else if (cnt <= 1024u) {
                unsigned ck[16];
#pragma unroll
                for (int jj = 0; jj < 16; ++jj) { const unsigned idx = jj * 64 + lane; ck[jj] = idx < cnt ? (unsigned)(cand[idx] >> 32) : 0u; }
#pragma unroll 1
                for (int bit = sb; bit >= 0; --bit) { const unsigned trial = thr | (1u << bit); unsigned c2 = 0u;
#pragma unroll
                    for (int jj = 0; jj < 16; ++jj) c2 += (unsigned)__popcll(__ballot(ck[jj] >= trial));
                    if (c2 >= 256u) thr = trial; }
            } else {
#pragma unroll 1
            for (int bit = sb; bit >= 0; --bit) { const unsigned trial = thr | (1u << bit); unsigned c2 = 0u;
                for (int jj = 0; jj < ns; ++jj) { const unsigned idx = jj * 64 + lane; const unsigned k = idx < cnt ? (unsigned)(cand[idx] >> 32) : 0u; c2 += (unsigned)__popcll(__ballot(k >= trial)); }
                if (c2 >= 256u) thr = trial; }
            }
            unsigned ngt = 0u;
            for (int jj = 0; jj < ns; ++jj) { const unsigned idx = jj * 64 + lane; const unsigned k = idx < cnt ? (unsigned)(cand[idx] >> 32) : 0u; ngt += (unsigned)__popcll(__ballot(k > thr)); }
            unsigned pg = 0u, pe = 0u;
            for (int jj = 0; jj < ns; ++jj) { const unsigned idx = jj * 64 + lane; const unsigned long long cv = idx < cnt ? cand[idx] : 0ull; const unsigned k = (unsigned)(cv >> 32);
                const bool gt = k > thr, eq = (idx < cnt) && (k == thr); const unsigned long long mg = __ballot(gt), me = __ballot(eq);
                const unsigned sidx = (unsigned)cv; bool take = gt;
                if (eq) { const unsigned e = pe + (unsigned)__popcll(me & lt); take = take || (ngt + e < 256u); }
                if (take) __hip_atomic_fetch_or(&bm[sidx >> 5], 1u << (sidx & 31u), __ATOMIC_RELAXED, __HIP_MEMORY_SCOPE_WORKGROUP);
                pg += (unsigned)__popcll(mg); pe += (unsigned)__popcll(me); }
        } else {
#pragma unroll 1
            for (int bit = sb; bit >= 0; --bit) { const unsigned trial = thr | (1u << bit); unsigned c2 = 0u;
                for (int ch = 0; ch < nch; ++ch) { const int s = ch * 64 + lane; const unsigned k = s < n ? f2key(row[s]) : 0u; c2 += (unsigned)__popcll(__ballot(k >= trial)); }
                if (c2 >= 256u) thr = trial; }
            unsigned ngt = 0u;
            for (int ch = 0; ch < nch; ++ch) { const int s = ch * 64 + lane; const unsigned k = s < n ? f2key(row[s]) : 0u; ngt += (unsigned)__popcll(__ballot(k > thr)); }
            unsigned pg = 0u, pe = 0u;
            for (int ch = 0; ch < nch; ++ch) { const int s = ch * 64 + lane; const unsigned k = s < n ? f2key(row[s]) : 0u;
                const bool gt = k > thr, eq = (s < n) && (k == thr); const unsigned long long mg = __ballot(gt), me = __ballot(eq);
                bool take = gt;
                if (eq) { const unsigned e = pe + (unsigned)__popcll(me & lt); take = take || (ngt + e < 256u); }
                if (take) __hip_atomic_fetch_or(&bm[(unsigned)s >> 5], 1u << ((unsigned)s & 31u), __ATOMIC_RELAXED, __HIP_MEMORY_SCOPE_WORKGROUP);
                pg += (unsigned)__popcll(mg); pe += (unsigned)__popcll(me); }
        }
        LDS_WAIT();
        { u32x4 wv = *(const LAS u32x4*)(bm + 4 * lane);
          const unsigned cl = (unsigned)(__popc(wv.x) + __popc(wv.y) + __popc(wv.z) + __popc(wv.w));
          unsigned inc = cl;
#pragma unroll
          for (int o = 1; o < 64; o <<= 1) { const unsigned tv = (unsigned)__shfl_up((int)inc, o); if (lane >= o) inc += tv; }
          unsigned pos = inc - cl;
#pragma unroll
          for (int jw = 0; jw < 4; ++jw) { unsigned wd = wv[jw]; while (wd) { const int bp = __ffs((int)wd) - 1; if (pos < 256u) sel[pos] = (4 * lane + jw) * 32 + bp; ++pos; wd &= wd - 1u; } } }
        LDS_WAIT();
    }
}

__device__ __forceinline__ void odd_attn(Frame& F, const int probe = 0) {
    const bf16* QL = WSP(bf16, WS_QL); const bf16* KV = WSP(bf16, WS_KV); const int* SEL = WSP(int, WS_SEL); bf16* OL = probe ? WSP(bf16, WS_S + 128 * MiB) : WSP(bf16, WS_OLAT);
    const int pmask = probe == 1 ? 255 : 0x7fffffff;
    constexpr int CHB = 16 * 1152;
    const int lane = F.lane, w = F.wave, qi = w >> 1, hw = w & 1, fr = lane & 15, fq = lane >> 4;
    LAS int* SLq = (LAS int*)(F.lds + 8 * CHB) + qi * 256;
    LAS unsigned char* XS = F.lds + 8 * CHB + 4096;
    int pk[9];
#pragma unroll
    for (int i = 0; i < 9; ++i) { const int p = 576 * hw + 64 * i + lane, row = p / 72, slot = p % 72; pk[i] = row * 128 + (slot ^ ((row >> 1) & 7)); }
    const int gA = (fr >> 1) & 7;
    const int trow = 4 * fq + (fr >> 2), gT = (trow >> 1) & 7;
    u32x2 selv = (u32x2){0u, 0u};
    if (F.cid < T / 4) selv = *(const u32x2*)(SEL + (size_t)(F.cid * 4 + qi) * 256 + hw * 128 + lane * 2);
    for (int grp = F.cid; grp < T / 4; grp += F.G) {
        const int t = grp * 4 + qi; const int nsel = (t + 1) < 256 ? (t + 1) : 256;
        const int nmax = (grp * 4 + 4) < 256 ? (grp * 4 + 4) : 256; const int nch = (nmax + 15) >> 4;
        __syncthreads();
        { const int i0 = hw * 128 + lane * 2; const int v0 = i0 < nsel ? (int)selv.x : 0, v1 = (i0 + 1) < nsel ? (int)selv.y : 0; SLq[i0] = v0 & pmask; SLq[i0 + 1] = v1 & pmask; }
        if (grp + F.G < T / 4) selv = *(const u32x2*)(SEL + (size_t)((grp + F.G) * 4 + qi) * 256 + hw * 128 + lane * 2);
#pragma unroll
        for (int i_ = 0; i_ < 9; ++i_) { const int row_ = pk[i_] >> 7, c16_ = pk[i_] & 127;
            __builtin_amdgcn_global_load_lds((const unsigned*)(QL + (size_t)t * QLD + row_ * 576 + c16_ * 8), (LAS unsigned*)(F.lds + (4 + qi) * CHB + 9216 * hw + 1024 * i_), 16, 0, 0); }
        __syncthreads();
#define AT_DMA(chn, bufn) do { _Pragma("unroll") for (int i_ = 0; i_ < 9; ++i_) { const int row_ = pk[i_] >> 7, c16_ = pk[i_] & 127; \
            __builtin_amdgcn_global_load_lds((const unsigned*)(KV + (size_t)SLq[16 * (chn) + row_] * 576 + c16_ * 8), (LAS unsigned*)(F.lds + ((bufn) * 4 + qi) * CHB + 9216 * hw + 1024 * i_), 16, 0, 0); } } while (0)
        AT_DMA(0, 0);
        VM_WAIT(); __syncthreads();
        bf16x8 qf[9];
        { const LAS unsigned char* qr = F.lds + (4 + qi) * CHB + fr * 1152;
#pragma unroll
          for (int j = 0; j < 9; ++j) qf[j] = *(const LAS bf16x8*)(qr + ((8 * j + 4 * hw + fq) ^ gA) * 16); }
        LDS_WAIT(); __syncthreads();
        f32x4 o[16];
#pragma unroll
        for (int q = 0; q < 16; ++q) o[q] = (f32x4){0.f, 0.f, 0.f, 0.f};
        float m_run = -INFINITY, l_run = 0.f;
#pragma unroll 1
        for (int ch = 0; ch < nch; ++ch) {
            const LAS unsigned char* cb = F.lds + ((ch & 1) * 4 + qi) * CHB;
            if (ch + 1 < nch && probe < 3) AT_DMA(ch + 1, (ch + 1) & 1);
            f32x4 s = (f32x4){0.f, 0.f, 0.f, 0.f}, s2 = s;
            const LAS unsigned char* ar = cb + fr * 1152; const int ca = 4 * hw + fq;
#pragma unroll
            for (int j = 0; j < 8; j += 2) { const bf16x8 a = *(const LAS bf16x8*)(ar + ((8 * j + ca) ^ gA) * 16), a2 = *(const LAS bf16x8*)(ar + ((8 * (j + 1) + ca) ^ gA) * 16);
                s = mma16(a, qf[j], s); s2 = mma16(a2, qf[j + 1], s2); }
            { const bf16x8 a = *(const LAS bf16x8*)(ar + ((64 + ca) ^ gA) * 16); s = mma16(a, qf[8], s); }
            s = s + s2;
            *(LAS f32x4*)(XS + (w * 64 + lane) * 16) = s;
            LDS_WAIT(); __syncthreads();
            s = s + *(const LAS f32x4*)(XS + ((w ^ 1) * 64 + lane) * 16);
            float cm = -INFINITY;
#pragma unroll
            for (int i = 0; i < 4; ++i) { s[i] = (16 * ch + 4 * fq + i) < nsel ? s[i] : -INFINITY; cm = fmaxf(cm, s[i]); }
            cm = fmaxf(cm, __shfl_xor(cm, 16)); cm = fmaxf(cm, __shfl_xor(cm, 32));
            const float m_new = fmaxf(m_run, cm);
            if (__any(m_new > m_run)) { const float al = exp2f(m_run - m_new);
#pragma unroll
                for (int q = 0; q < 16; ++q) o[q] = o[q] * al;
                l_run *= al; m_run = m_new; }
            const float p0 = exp2f(s[0] - m_run), p1 = exp2f(s[1] - m_run), p2 = exp2f(s[2] - m_run), p3 = exp2f(s[3] - m_run);
            l_run += (p0 + p1) + (p2 + p3);
            const u32x2 pb = (u32x2){pk2(p0, p1), pk2(p2, p3)}; const s16x4 bfr = __builtin_bit_cast(s16x4, pb);
            const LAS unsigned char* vr = cb + trow * 1152 + 8 * (fr & 1); const int c0 = (32 * hw + ((fr & 3) >> 1)) ^ gT;
#pragma unroll
            for (int q = 0; q < 16; ++q) { const s16x4 af = __builtin_bit_cast(s16x4, __builtin_amdgcn_ds_read_tr16_b64_v4i16((LAS s16x4*)(vr + ((c0 ^ (2 * q)) * 16))));
                o[q] = __builtin_amdgcn_mfma_f32_16x16x16bf16_1k(af, bfr, o[q], 0, 0, 0); if ((q & 3) == 3) __builtin_amdgcn_sched_barrier(0); }
            VM_WAIT(); LDS_WAIT(); __syncthreads();
        }
#undef AT_DMA
        float lt = l_run; lt += __shfl_xor(lt, 16); lt += __shfl_xor(lt, 32);
        const float inv = 1.f / lt;
        { LAS unsigned char* os = F.lds + qi * CHB + fr * 1056 + 512 * hw + 8 * fq;
#pragma unroll
          for (int q = 0; q < 16; ++q) { u32x2 ov; ov.x = pk2(o[q][0] * inv, o[q][1] * inv); ov.y = pk2(o[q][2] * inv, o[q][3] * inv); *(LAS u32x2*)(os + 32 * q) = ov; } }
        LDS_WAIT(); __syncthreads();
        { const LAS unsigned char* os = F.lds + qi * CHB + (8 * hw) * 1056 + lane * 16; bf16* op = OL + (size_t)t * 8192 + (8 * hw) * 512 + lane * 8;
#pragma unroll
          for (int hh = 0; hh < 8; ++hh) *(u32x4*)(op + hh * 512) = *(const LAS u32x4*)(os + hh * 1056); }
    }
    __syncthreads();
}

__device__ __forceinline__ void ln1_router(Frame& F, int layer, const bool do_route = true) {
    const bf16* H = WSP(bf16, WS_H); bf16* XB = WSP(bf16, WS_XB);
    const float* RT = WSP(float, WS_RT) + (size_t)layer * 36 * D;
    int* ROWTOK_ = WSP(int, WS_ROUTE); float* ROWGATE_ = WSP(float, WS_ROUTE + 1 * MiB); int* ASSIGN = WSP(int, WS_ROUTE + 2 * MiB);
    const float* g1 = FIN(17) + (size_t)layer * D; const float* b1 = FIN(18) + (size_t)layer * D;
    const float* gb = FIN(22) + layer * 4; const float* eb = FIN(24) + layer * 32;
    gu32* cnt = F_CTL + CW_CNT + layer * 32 * 64;
    const int lane = F.lane;
    constexpr int RB = 4;
    for (int m0 = F.gw * RB; m0 < T; m0 += F.NGW * RB) {
        f32x4 v[RB][8];
#pragma unroll
        for (int r = 0; r < RB; ++r) {
            const u32x4* hr = (const u32x4*)(H + (size_t)(m0 + r) * D) + lane; float s = 0.f;
#pragma unroll
            for (int j2 = 0; j2 < 4; ++j2) { const u32x4 hw4 = hr[64 * j2];
                v[r][2 * j2] = (f32x4){bflo(hw4.x), bfhi(hw4.x), bflo(hw4.y), bfhi(hw4.y)}; v[r][2 * j2 + 1] = (f32x4){bflo(hw4.z), bfhi(hw4.z), bflo(hw4.w), bfhi(hw4.w)};
                s += ((v[r][2 * j2][0] + v[r][2 * j2][1]) + (v[r][2 * j2][2] + v[r][2 * j2][3])) + ((v[r][2 * j2 + 1][0] + v[r][2 * j2 + 1][1]) + (v[r][2 * j2 + 1][2] + v[r][2 * j2 + 1][3])); }
            const float mean = wave_sum(s) * (1.f / D); float s2 = 0.f;
#pragma unroll
            for (int jj = 0; jj < 8; ++jj) { v[r][jj] = v[r][jj] - mean; s2 += (v[r][jj][0] * v[r][jj][0] + v[r][jj][1] * v[r][jj][1]) + (v[r][jj][2] * v[r][jj][2] + v[r][jj][3] * v[r][jj][3]); }
            const float rstd = rsqrtf(wave_sum(s2) * (1.f / D) + LN_EPS);
#pragma unroll
            for (int j2 = 0; j2 < 4; ++j2) { const int q4 = 2 * (lane + 64 * j2);
                const f32x4 gg0 = *((const f32x4*)g1 + q4), gg1 = *((const f32x4*)g1 + q4 + 1), bb0 = *((const f32x4*)b1 + q4), bb1 = *((const f32x4*)b1 + q4 + 1);
                v[r][2 * j2] = v[r][2 * j2] * rstd * gg0 + bb0; v[r][2 * j2 + 1] = v[r][2 * j2 + 1] * rstd * gg1 + bb1;
                u32x4 o; o.x = pk2(v[r][2 * j2][0], v[r][2 * j2][1]); o.y = pk2(v[r][2 * j2][2], v[r][2 * j2][3]); o.z = pk2(v[r][2 * j2 + 1][0], v[r][2 * j2 + 1][1]); o.w = pk2(v[r][2 * j2 + 1][2], v[r][2 * j2 + 1][3]);
                *((u32x4*)(XB + (size_t)(m0 + r) * D) + lane + 64 * j2) = o; }
        }
        float mylg[RB];
#pragma unroll
        for (int r = 0; r < RB; ++r) mylg[r] = 0.f;
#pragma unroll 1
        for (int e = 0; e < 36; ++e) { const f32x4* rr = (const f32x4*)(RT + (size_t)e * D) + 2 * lane; float p[RB];
#pragma unroll
            for (int r = 0; r < RB; ++r) p[r] = 0.f;
#pragma unroll
            for (int jj = 0; jj < 8; ++jj) { const f32x4 r4 = rr[128 * (jj >> 1) + (jj & 1)];
#pragma unroll
                for (int r = 0; r < RB; ++r) p[r] += (v[r][jj][0] * r4[0] + v[r][jj][1] * r4[1]) + (v[r][jj][2] * r4[2] + v[r][jj][3] * r4[3]); }
#pragma unroll
            for (int r = 0; r < RB; ++r) { const float q = wave_sum(p[r]); mylg[r] = (lane == e) ? q : mylg[r]; } }
        int e1r[RB], e2r[RB]; float ga1[RB], ga2[RB];
#pragma unroll
        for (int r = 0; r < RB; ++r) {
            float g0 = __shfl(mylg[r], 0) + gb[0], g1v = __shfl(mylg[r], 1) + gb[1], g2 = __shfl(mylg[r], 2) + gb[2], g3 = __shfl(mylg[r], 3) + gb[3];
            int gs = 0; float gm = g0;
            if (g1v > gm) { gm = g1v; gs = 1; } if (g2 > gm) { gm = g2; gs = 2; } if (g3 > gm) { gm = g3; gs = 3; }
            const float ggate = 1.f / (__expf(g0 - gm) + __expf(g1v - gm) + __expf(g2 - gm) + __expf(g3 - gm));
            float el[8];
#pragma unroll
            for (int k = 0; k < 8; ++k) el[k] = __shfl(mylg[r], 4 + gs * 8 + k) + eb[gs * 8 + k];
            int i1 = 0; float v1 = el[0];
#pragma unroll
            for (int k = 1; k < 8; ++k) if (el[k] > v1) { v1 = el[k]; i1 = k; }
            int i2 = -1; float v2 = -INFINITY;
#pragma unroll
            for (int k = 0; k < 8; ++k) if (k != i1 && el[k] > v2) { v2 = el[k]; i2 = k; }
            const float w1 = 1.f / (1.f + __expf(v2 - v1)), w2 = 1.f - w1;
            e1r[r] = gs * 8 + i1; e2r[r] = gs * 8 + i2; ga1[r] = w1 * ggate; ga2[r] = w2 * ggate;
        }
        if (do_route && lane < RB) {
            int e1 = e1r[0], e2 = e2r[0]; float q1 = ga1[0], q2 = ga2[0];
#pragma unroll
            for (int r = 1; r < RB; ++r) if (lane == r) { e1 = e1r[r]; e2 = e2r[r]; q1 = ga1[r]; q2 = ga2[r]; }
            const int m = m0 + lane;
            const unsigned p1 = __hip_atomic_fetch_add(cnt + e1 * 64, 1u, RLX_AGENT), p2 = __hip_atomic_fetch_add(cnt + e2 * 64, 1u, RLX_AGENT);
            ROWTOK_[e1 * CAP + p1] = m; ROWGATE_[e1 * CAP + p1] = q1; ROWTOK_[e2 * CAP + p2] = m; ROWGATE_[e2 * CAP + p2] = q2;
            ASSIGN[m * 2] = e1 * CAP + (int)p1; ASSIGN[m * 2 + 1] = e2 * CAP + (int)p2;
        }
    }
}
__device__ __forceinline__ void moe_tables(Frame& F, int layer) {
    LAS int* tab = (LAS int*)(F.lds + MOE_TAB_OFF);
    gu32* cnt = F_CTL + CW_CNT + layer * 32 * 64;
    __syncthreads();
    if (F.tid < 32) tab[40 + F.tid] = (int)__hip_atomic_load(cnt + F.tid * 64, RLX_AGENT);
    __syncthreads();
    if (F.tid == 0) { int a = 0; for (int e = 0; e < 32; ++e) { tab[e] = a; a += (tab[40 + e] + 255) >> 8; } tab[32] = a; }
    __syncthreads();
}
__device__ __forceinline__ void ln2_combine(Frame& F, int layer, const bool dummy_out = false) {
    const bf16* XBi = WSP(bf16, WS_XB); bf16* XB = dummy_out ? WSP(bf16, WS_U) : WSP(bf16, WS_XB); const bf16* YR = WSP(bf16, WS_YROWS); const int* ASSIGN = WSP(int, WS_ROUTE + 2 * MiB);
    const LAS int* tab = (const LAS int*)(F.lds + MOE_TAB_OFF);
    const float* g2 = FIN(19) + (size_t)layer * D; const float* b2 = FIN(20) + (size_t)layer * D;
    const int lane = F.lane;
    for (int m = F.gw; m < T; m += F.NGW) {
        const int a0 = ASSIGN[m * 2], a1 = ASSIGN[m * 2 + 1];
        const size_t r0 = (size_t)tab[a0 >> 13] * 256 + (a0 & (CAP - 1)), r1 = (size_t)tab[a1 >> 13] * 256 + (a1 & (CAP - 1));
        const u32x4* xr = (const u32x4*)(XBi + (size_t)m * D) + lane; const u32x4* y0 = (const u32x4*)(YR + r0 * D) + lane; const u32x4* y1 = (const u32x4*)(YR + r1 * D) + lane;
        f32x4 v[8]; float s = 0.f;
#pragma unroll
        for (int j2 = 0; j2 < 4; ++j2) { const u32x4 xv = xr[64 * j2]; const u32x4 p = y0[64 * j2], q = y1[64 * j2];
            v[2 * j2][0] = bflo(xv.x) * ALPHA + (bflo(p.x) + bflo(q.x)); v[2 * j2][1] = bfhi(xv.x) * ALPHA + (bfhi(p.x) + bfhi(q.x));
            v[2 * j2][2] = bflo(xv.y) * ALPHA + (bflo(p.y) + bflo(q.y)); v[2 * j2][3] = bfhi(xv.y) * ALPHA + (bfhi(p.y) + bfhi(q.y));
            v[2 * j2 + 1][0] = bflo(xv.z) * ALPHA + (bflo(p.z) + bflo(q.z)); v[2 * j2 + 1][1] = bfhi(xv.z) * ALPHA + (bfhi(p.z) + bfhi(q.z));
            v[2 * j2 + 1][2] = bflo(xv.w) * ALPHA + (bflo(p.w) + bflo(q.w)); v[2 * j2 + 1][3] = bfhi(xv.w) * ALPHA + (bfhi(p.w) + bfhi(q.w));
            s += ((v[2 * j2][0] + v[2 * j2][1]) + (v[2 * j2][2] + v[2 * j2][3])) + ((v[2 * j2 + 1][0] + v[2 * j2 + 1][1]) + (v[2 * j2 + 1][2] + v[2 * j2 + 1][3])); }
        const float mean = wave_sum(s) * (1.f / D); float s2 = 0.f;
#pragma unroll
        for (int jj = 0; jj < 8; ++jj) { v[jj] = v[jj] - mean; s2 += (v[jj][0] * v[jj][0] + v[jj][1] * v[jj][1]) + (v[jj][2] * v[jj][2] + v[jj][3] * v[jj][3]); }
        const float rstd = rsqrtf(wave_sum(s2) * (1.f / D) + LN_EPS);
#pragma unroll
        for (int j2 = 0; j2 < 4; ++j2) { const int q4 = 2 * (lane + 64 * j2);
            const f32x4 gg0 = *((const f32x4*)g2 + q4), gg1 = *((const f32x4*)g2 + q4 + 1), bb0 = *((const f32x4*)b2 + q4), bb1 = *((const f32x4*)b2 + q4 + 1);
            v[2 * j2] = v[2 * j2] * rstd * gg0 + bb0; v[2 * j2 + 1] = v[2 * j2 + 1] * rstd * gg1 + bb1;
            u32x4 o; o.x = pk2(v[2 * j2][0], v[2 * j2][1]); o.y = pk2(v[2 * j2][2], v[2 * j2][3]); o.z = pk2(v[2 * j2 + 1][0], v[2 * j2 + 1][1]); o.w = pk2(v[2 * j2 + 1][2], v[2 * j2 + 1][3]);
            *((u32x4*)(XB + (size_t)m * D) + lane + 64 * j2) = o; }
    }
}

#ifndef MK_SPLIT
#define MK_SPLIT 0
#endif
constexpr int NPHASE = 47;
struct Args { const float* in[31]; float* out; unsigned char* ws; int ph_lo, ph_hi; };

#define IN(k) (lo <= (k) && (k) < hi)
#define SEAM(k) do { if (!MK_SPLIT && (k) + 1 < hi) { XcdBarrier bar; bar.bar = (unsigned*)(F_CTL + CW_BAR); bar.x = xb_xcc_id(); bar.st = (volatile LAS unsigned*)(F.lds + MISC_OFF) + 8; xcd_barrier(bar); } } while (0)
#define tab ((LAS int*)(F.lds + MOE_TAB_OFF))
#define ROWTOK WSP(int, WS_ROUTE)
#define ROWGATE WSP(float, WS_ROUTE + 1 * MiB)
#ifndef PROBE_TOPK
#define PROBE_TOPK 0
#endif
#ifndef PROBE_MASK
#define PROBE_MASK 0u
#endif
#define PHASE(k, g, ...) if (IN(k)) { PHASE_BEGIN(); __VA_ARGS__; SEAM(k); } if ((g) >= 0 && ((PROBE_MASK >> ((g) & 31)) & 1u)) { if (IN(k)) { PHASE_BEGIN(); __VA_ARGS__; SEAM2(k); } }
#define PHASE2(k, g, FIRST, SECOND) if (IN(k)) { PHASE_BEGIN(); FIRST; SEAM(k); } if ((PROBE_MASK >> ((g) & 31)) & 1u) { if (IN(k)) { PHASE_BEGIN(); SECOND; SEAM2(k); } }
#define SEAM2(k) do { if (!MK_SPLIT) { XcdBarrier bar; bar.bar = (unsigned*)(F_CTL + CW_BAR); bar.x = xb_xcc_id(); bar.st = (volatile LAS unsigned*)(F.lds + MISC_OFF) + 8; xcd_barrier(bar); } } while (0)
__device__ __forceinline__ void ple_phase(Frame& F, int layer, float* Xout, bf16* XBout) {
    pg8::Gemm g{2048, 2048, 2048}; pg8::SchedDense S; S.init(32, 8, F.G, F.cid, WSP(bf16, WS_XB), (size_t)256 * 2048 * 2, WSP(bf16, WS_WPG) + (size_t)layer * 2048 * 2048, (size_t)256 * 2048 * 2);
    pg8::EpiPle E{WSP(bf16, WS_XB), Xout, XBout, WSP(bf16, WS_PP), FIN(30) + (size_t)layer * D};
    pg8::gemm_phase<pg8::EpiPle, pg8::SchedDense, true, false>(F.lds, g, S, E, F.tid);
}
template <int j> __device__ __forceinline__ void layer_pair(Frame& F, const int lo, const int hi) {
        const int b = 1 + 23 * j, o = b + 11, le = 2 * j, lod = 2 * j + 1;
        PHASE(b + 0, 1,
            pg8::Gemm g{2048, 2048, 2048}; pg8::SchedDense S; S.init(32, 26, F.G, F.cid, WSP(bf16, WS_XBN), (size_t)256 * 2048 * 2, WSP(bf16, WS_WIN_E) + (size_t)j * EV_INP * 2048, (size_t)256 * 2048 * 2);
            pg8::EpiBf16 E{WSP(bf16, WS_U), EV_INP, 1.f};
            pg8::gemm_phase<pg8::EpiBf16, pg8::SchedDense, true, false>(F.lds, g, S, E, F.tid);
            if (j == 0) moe_cvt_tail(F, 32 * 26, 0, 0, MOE_SEG0); else moe_cvt_tail(F, 32 * 26, 2, MOE_SEG0, MOE_SEG1);)
        PHASE(b + 2, 3,  even_states(F, j); even_swa(F, j);)
        PHASE(b + 3, 4,  even_scan(F);)
        PHASE(b + 4, 5,  even_y(F, j);)
        PHASE(b + 5, 6,
            pg8::Gemm g{3072, 3072, 3072}; pg8::SchedDense S; S.init(32, 8, F.G, F.cid, WSP(bf16, WS_YMIX), (size_t)256 * 3072 * 2, WSP(bf16, WS_WOUT_E) + (size_t)j * 2048 * 3072, (size_t)256 * 3072 * 2);
            pg8::EpiRes E{WSP(bf16, WS_XBN), WSP(bf16, WS_H)};
            pg8::gemm_phase<pg8::EpiRes, pg8::SchedDense, true, false>(F.lds, g, S, E, F.tid);)
        PHASE2(b + 6, 16, ln1_router(F, le), ln1_router(F, le, false))
        PHASE(b + 7, 7,
            moe_tables(F, le);
            pg8::Gemm g{2048, 2048, 2048}; pg8::SchedMoe<4, true> S; S.init(tab, F.G, F.cid, WSP(bf16, WS_XB), WSP(bf16, WS_WGU) + (size_t)le * 32 * 1024 * 2048, (size_t)1024 * 2048 * 2, (size_t)256 * 2048 * 2, ROWTOK);
            pg8::EpiGateUp E{WSP(bf16, WS_HID)};
            pg8::gemm_phase<pg8::EpiGateUp, pg8::SchedMoe<4, true>, true, true>(F.lds, g, S, E, F.tid);
            moe_cvt_tail(F, tab[32] * 4, lod, 0, MOE_SEG0);)
        PHASE(b + 8, 8,
            { pg8::Gemm g{512, 512, 512}; pg8::SchedMoe<8, false> S; S.init(tab, F.G, F.cid, WSP(bf16, WS_HID), WSP(bf16, WS_WD) + (size_t)le * 32 * 2048 * 512, (size_t)2048 * 512 * 2, (size_t)256 * 512 * 2, ROWTOK);
              pg8::EpiDown E{WSP(bf16, WS_YROWS), ROWGATE, tab};
              pg8::gemm_phase<pg8::EpiDown, pg8::SchedMoe<8, false>, true, false>(F.lds, g, S, E, F.tid); }
            { pg8::Gemm g{256, 256, 256}; pg8::SchedDense S; S.init(32, 8, F.G, F.cid, WSP(bf16, WS_PB) + (size_t)le * T * 256, (size_t)256 * 256 * 2, WSP(bf16, WS_WPP) + (size_t)le * 2048 * 256, (size_t)256 * 256 * 2);
              pg8::EpiBf16 E{WSP(bf16, WS_PP), D, 1.f};
              pg8::gemm_phase<pg8::EpiBf16, pg8::SchedDense, true, false>(F.lds, g, S, E, F.tid); })
        PHASE2(b + 9, 17, ln2_combine(F, le), ln2_combine(F, le, true))
        PHASE2(b + 10, 18, ple_phase(F, le, nullptr, WSP(bf16, WS_XBN)), ple_phase(F, le, nullptr, WSP(bf16, WS_U)))
        PHASE(o + 0, 9,
            pg8::Gemm g{2048, 2048, 2048}; pg8::SchedDense S; S.init(32, 19, F.G, F.cid, WSP(bf16, WS_XBN), (size_t)256 * 2048 * 2, WSP(bf16, WS_WIN_O) + (size_t)j * OD_INP * 2048, (size_t)256 * 2048 * 2);
            pg8::EpiBf16 E{WSP(bf16, WS_U), OD_INP, 1.f};
            pg8::gemm_phase<pg8::EpiBf16, pg8::SchedDense, true, false>(F.lds, g, S, E, F.tid);
            moe_cvt_tail(F, 32 * 19, lod, MOE_SEG0, MOE_SEG1);)
        PHASE(o + 1, 10,
            odd_prep(F, j);
            pg8::Gemm g{OD_INP, 128, 128}; pg8::SchedDense S; S.init(32, 32, F.G, F.cid, WSP(bf16, WS_U), (size_t)256 * OD_INP * 2, WSP(bf16, WS_WUK) + (size_t)j * 8192 * 128, (size_t)256 * 128 * 2);
            S.a_cdiv = 2; S.a_cstride = 192 * 2; S.n_div = 2; S.n_stride = 576;
            pg8::EpiBf16 E{WSP(bf16, WS_QL), QLD, MLA_QSCALE};
            pg8::gemm_phase<pg8::EpiBf16, pg8::SchedDense, true, false>(F.lds, g, S, E, F.tid);)
        PHASE(o + 2, 11,  odd_scores(F);)
        PHASE2(o + 3, 12, odd_topk(F), odd_topk(F, PROBE_TOPK))
        PHASE2(o + 4, 13, odd_attn(F), odd_attn(F, PROBE_TOPK))
        PHASE(o + 5, 14,
            pg8::Gemm g{8192, 1024, 1024}; pg8::SchedDense S; S.init(32, 8, F.G, F.cid, WSP(bf16, WS_OLAT), (size_t)256 * 8192 * 2, WSP(bf16, WS_WUV) + (size_t)j * 2048 * 1024, (size_t)256 * 1024 * 2);
            S.a_cdiv = 1; S.a_cstride = 1024 * 2;
            pg8::EpiBf16 E{WSP(bf16, WS_O), D, 1.f};
            pg8::gemm_phase<pg8::EpiBf16, pg8::SchedDense, true, false>(F.lds, g, S, E, F.tid);)
        PHASE(o + 6, 15,
            pg8::Gemm g{2048, 2048, 2048}; pg8::SchedDense S; S.init(32, 8, F.G, F.cid, WSP(bf16, WS_O), (size_t)256 * 2048 * 2, WSP(bf16, WS_WOUT_O) + (size_t)j * 2048 * 2048, (size_t)256 * 2048 * 2);
            pg8::EpiRes E{WSP(bf16, WS_XBN), WSP(bf16, WS_H)};
            pg8::gemm_phase<pg8::EpiRes, pg8::SchedDense, true, false>(F.lds, g, S, E, F.tid);)
        PHASE2(o + 7, 16, ln1_router(F, lod), ln1_router(F, lod, false))
        PHASE(o + 8, 7,
            moe_tables(F, lod);
            pg8::Gemm g{2048, 2048, 2048}; pg8::SchedMoe<4, true> S; S.init(tab, F.G, F.cid, WSP(bf16, WS_XB), WSP(bf16, WS_WGU) + (size_t)lod * 32 * 1024 * 2048, (size_t)1024 * 2048 * 2, (size_t)256 * 2048 * 2, ROWTOK);
            pg8::EpiGateUp E{WSP(bf16, WS_HID)};
            pg8::gemm_phase<pg8::EpiGateUp, pg8::SchedMoe<4, true>, true, true>(F.lds, g, S, E, F.tid);
            if (j == 0) moe_cvt_tail(F, tab[32] * 4, 2, 0, MOE_SEG0);)
        PHASE(o + 9, 8,
            { pg8::Gemm g{512, 512, 512}; pg8::SchedMoe<8, false> S; S.init(tab, F.G, F.cid, WSP(bf16, WS_HID), WSP(bf16, WS_WD) + (size_t)lod * 32 * 2048 * 512, (size_t)2048 * 512 * 2, (size_t)256 * 512 * 2, ROWTOK);
              pg8::EpiDown E{WSP(bf16, WS_YROWS), ROWGATE, tab};
              pg8::gemm_phase<pg8::EpiDown, pg8::SchedMoe<8, false>, true, false>(F.lds, g, S, E, F.tid); }
            { pg8::Gemm g{256, 256, 256}; pg8::SchedDense S; S.init(32, 8, F.G, F.cid, WSP(bf16, WS_PB) + (size_t)lod * T * 256, (size_t)256 * 256 * 2, WSP(bf16, WS_WPP) + (size_t)lod * 2048 * 256, (size_t)256 * 256 * 2);
              pg8::EpiBf16 E{WSP(bf16, WS_PP), D, 1.f};
              pg8::gemm_phase<pg8::EpiBf16, pg8::SchedDense, true, false>(F.lds, g, S, E, F.tid); })
        PHASE2(o + 10, 17, ln2_combine(F, lod), ln2_combine(F, lod, true))
        PHASE2(o + 11, 18, ple_phase(F, lod, j == 1 ? F_OUT : nullptr, WSP(bf16, WS_XBN)), ple_phase(F, lod, j == 1 ? WSP(float, WS_H) : nullptr, WSP(bf16, WS_U)))
    }
__global__ void __launch_bounds__(512, 2) fwd_kernel(Args args) {
    extern __shared__ __attribute__((aligned(16))) unsigned char lds_raw[];
    Frame F;
    F.lds = (LAS unsigned char*)lds_raw;
    F.tid = threadIdx.x; F.lane = F.tid & 63; F.wave = __builtin_amdgcn_readfirstlane(F.tid >> 6);
    F.G = gridDim.x; F.cid = blockIdx.x; F.gw = F.cid * 8 + F.wave; F.NGW = F.G * 8;
    F.ws = args.ws;
    F.ka = (const __attribute__((address_space(4))) unsigned char*)__builtin_amdgcn_kernarg_segment_ptr();
    for (int u = F.tid; u < (LDS_BYTES - LDSCTL_OFF) / 4; u += 512) ((LAS unsigned*)(F.lds + LDSCTL_OFF))[u] = 0u;
    __syncthreads();
    if (!MK_SPLIT) (void)xcd_barrier_post((unsigned*)(F_CTL + CW_BAR), (volatile LAS unsigned*)(F.lds + MISC_OFF) + 8);
    const int lo = args.ph_lo, hi = args.ph_hi;

    PHASE(0, 0, p0_prologue(F))
    layer_pair<0>(F, lo, hi);
    layer_pair<1>(F, lo, hi);
#undef IN
#undef SEAM
#undef tab
#undef ROWTOK
#undef ROWGATE
}

extern "C" void kernel_launch(void* const* d_in, const int* in_sizes, int n_in, void* d_out, int out_size, void* d_ws, size_t ws_size, hipStream_t stream) {
    static int grid = 0;
    if (grid == 0) {
        if (n_in != 31 || out_size != T * D || ws_size < WS_TOTAL) { fprintf(stderr, "kernel_launch: unexpected problem (n_in %d, out %d, ws %zu < %zu); nothing launched\n", n_in, out_size, ws_size, (size_t)WS_TOTAL); grid = -1; return; }
        int dev = 0, cus = 0, per_cu = 0;
        if (hipGetDevice(&dev) != hipSuccess || hipDeviceGetAttribute(&cus, hipDeviceAttributeMultiprocessorCount, dev) != hipSuccess) { grid = -1; return; }
        if (hipFuncSetAttribute((const void*)fwd_kernel, hipFuncAttributeMaxDynamicSharedMemorySize, LDS_BYTES) != hipSuccess) { fprintf(stderr, "kernel_launch: hipFuncSetAttribute failed\n"); grid = -1; return; }
        if (hipOccupancyMaxActiveBlocksPerMultiprocessor(&per_cu, (const void*)fwd_kernel, 512, LDS_BYTES) != hipSuccess || per_cu < 1) { fprintf(stderr, "kernel_launch: occupancy query reports %d blocks per CU\n", per_cu); }
        (void)hipGetLastError();
        grid = cus;
    }
    if (grid < 0) return;
    (void)hipMemsetAsync((char*)d_ws + WS_CTL, 0, CTL_ZERO_BYTES, stream);
    Args a{};
    for (int i = 0; i < 31; ++i) a.in[i] = (const float*)d_in[i];
    a.out = (float*)d_out; a.ws = (unsigned char*)d_ws;
#if MK_SPLIT
    for (int p = 0; p < NPHASE; ++p) { a.ph_lo = p; a.ph_hi = p + 1; hipLaunchKernelGGL(fwd_kernel, dim3(grid), dim3(512), LDS_BYTES, stream, a); }
#else
    a.ph_lo = 0; a.ph_hi = NPHASE;
    hipLaunchKernelGGL(fwd_kernel, dim3(grid), dim3(512), LDS_BYTES, stream, a);
#endif
    const hipError_t le = hipPeekAtLastError();
    if (le != hipSuccess) fprintf(stderr, "kernel_launch: launch failed: %s\n", hipGetErrorName(le));
}
```

```cpp
#include <hip/hip_runtime.h>
#include <cstdio>
#include <cstdint>

#define GAS __attribute__((address_space(1)))
#define LAS __attribute__((address_space(3)))
typedef unsigned short bf16;
typedef short bf16x8 __attribute__((ext_vector_type(8)));
typedef short s16x4 __attribute__((ext_vector_type(4)));
typedef float f32x4 __attribute__((ext_vector_type(4)));
typedef float f32x2 __attribute__((ext_vector_type(2)));
typedef unsigned u32x4 __attribute__((ext_vector_type(4)));
typedef unsigned u32x2 __attribute__((ext_vector_type(2)));
typedef GAS unsigned gu32;

constexpr int T = 8192, D = 2048, DEPTH = 4;
constexpr int EV_IN = 6432, EV_INP = 6656, EV_MIX = 3072;
constexpr int OD_IN = 4752, OD_INP = 4864;
constexpr int NEXP = 32, FF = 512, CAP = 8192;
constexpr int MAXROWS = 24576;
constexpr float LN_EPS = 1e-5f;
constexpr float ALPHA = 1.681792830507429f;
constexpr float LOG2E = 1.4426950408889634f;
constexpr int UE_Z = 0, UE_XBC = 2048, UE_Q = 5120, UE_K = 6144, UE_V = 6272, UE_DT = 6400;
constexpr int UO_Q = 0, UO_CKV = 3072, UO_QI = 3584, UO_KR = 4608, UO_KI = 4672, UO_WI = 4736;
constexpr int QLD = 9216;
constexpr float MLA_QSCALE = 0.07216878364870322f * LOG2E;
constexpr float SWA_QSCALE = 0.125f * LOG2E;

constexpr size_t MiB = 1u << 20;
constexpr size_t WS_CTL = 0, CTL_ZERO_BYTES = 1 * MiB;
constexpr size_t WS_RT = 1 * MiB;
constexpr size_t WS_COS = 3 * MiB, WS_SIN = 4 * MiB;
constexpr size_t WS_ROUTE = 5 * MiB;
constexpr size_t WS_WIN_E = 8 * MiB;
constexpr size_t WS_WOUT_E = 60 * MiB;
constexpr size_t WS_WIN_O = 84 * MiB;
constexpr size_t WS_WUK = 122 * MiB;
constexpr size_t WS_WUV = 126 * MiB;
constexpr size_t WS_WOUT_O = 134 * MiB;
constexpr size_t WS_WPG = 150 * MiB;
constexpr size_t WS_WPP = 182 * MiB;
constexpr size_t WS_WGU = 186 * MiB;
constexpr size_t WS_WD = 698 * MiB;
constexpr size_t WS_X = 954 * MiB;
constexpr size_t WS_H = 1018 * MiB;
constexpr size_t WS_XB = 1082 * MiB;
constexpr size_t WS_PB = 1114 * MiB;
constexpr size_t WS_PP = 1130 * MiB;
constexpr size_t WS_U = 1162 * MiB;
constexpr size_t WS_HID = 1266 * MiB;
constexpr size_t WS_YROWS = 1290 * MiB;
constexpr size_t WS_LAYER = 1386 * MiB;
constexpr size_t WS_XC = WS_LAYER;
constexpr size_t WS_DT = WS_LAYER + 48 * MiB;
constexpr size_t WS_ACS = WS_LAYER + 49 * MiB;
constexpr size_t WS_STATES = WS_LAYER + 50 * MiB;
constexpr size_t WS_PREVB = WS_LAYER + 114 * MiB;
constexpr size_t WS_YMIX = WS_LAYER + 146 * MiB;
constexpr size_t WS_KV = WS_LAYER;
constexpr size_t WS_QI = WS_LAYER + 10 * MiB;
constexpr size_t WS_KI = WS_LAYER + 26 * MiB;
constexpr size_t WS_WI = WS_LAYER + 27 * MiB;
constexpr size_t WS_SEL = WS_LAYER + 28 * MiB;
constexpr size_t WS_O = WS_LAYER + 36 * MiB;
constexpr size_t WS_QL = WS_LAYER + 68 * MiB;
constexpr size_t WS_S = WS_LAYER + 212 * MiB;
constexpr size_t WS_OLAT = WS_S;
constexpr size_t WS_END = WS_LAYER + 468 * MiB;
constexpr size_t WS_XBN = WS_END;
constexpr size_t WS_TOTAL = WS_END + 32 * MiB;

constexpr int CW_TMO = 0, CW_CODE = 1;
constexpr int CW_BAR = 4096;
constexpr int CW_CNT = 16384;

constexpr int RING_BYTES = 131072;
constexpr int LDSCTL_OFF = 159744;
constexpr int MISC_OFF = LDSCTL_OFF + 320;
constexpr int MOE_TAB_OFF = LDSCTL_OFF + 512;
constexpr int LDS_BYTES = 161792;

#define RLX_AGENT __ATOMIC_RELAXED, __HIP_MEMORY_SCOPE_AGENT
#define LDS_WAIT() asm volatile("s_waitcnt lgkmcnt(0)" ::: "memory")
#define VM_WAIT() asm volatile("s_waitcnt vmcnt(0)" ::: "memory")

__device__ __forceinline__ unsigned f2bf(float f) { unsigned u = __builtin_bit_cast(unsigned, f); return (u + 0x7fffu + ((u >> 16) & 1u)) >> 16; }
__device__ __forceinline__ unsigned pk2(float lo, float hi) { return f2bf(lo) | (f2bf(hi) << 16); }
__device__ __forceinline__ float bf2f(unsigned short b) { return __builtin_bit_cast(float, ((unsigned)b) << 16); }
__device__ __forceinline__ float bflo(unsigned w) { return __builtin_bit_cast(float, w << 16); }
__device__ __forceinline__ float bfhi(unsigned w) { return __builtin_bit_cast(float, w & 0xffff0000u); }
#define dppf(old, v, ctrl, rmask) __builtin_bit_cast(float, __builtin_amdgcn_update_dpp(__builtin_bit_cast(int, (float)(old)), __builtin_bit_cast(int, (float)(v)), ctrl, rmask, 0xF, false))
#define DPP_ROW_REDUCE(v, OP) do { v = OP(v, dppf(v, v, 0xB1, 0xF)); v = OP(v, dppf(v, v, 0x4E, 0xF)); v = OP(v, dppf(v, v, 0x141, 0xF)); v = OP(v, dppf(v, v, 0x140, 0xF)); } while (0)
__device__ __forceinline__ float op_add(float a, float b) { return a + b; }
__device__ __forceinline__ float op_max(float a, float b) { return fmaxf(a, b); }
__device__ __forceinline__ float grp16_sum(float v) { DPP_ROW_REDUCE(v, op_add); return v; }
__device__ __forceinline__ float grp16_max(float v) { DPP_ROW_REDUCE(v, op_max); return v; }
__device__ __forceinline__ float wave_sum(float v) {
    DPP_ROW_REDUCE(v, op_add);
    v += dppf(0.f, v, 0x142, 0xA); v += dppf(0.f, v, 0x143, 0xC);
    return __builtin_bit_cast(float, __builtin_amdgcn_readlane(__builtin_bit_cast(int, v), 63));
}
__device__ __forceinline__ float wave_max(float v) {
    DPP_ROW_REDUCE(v, op_max);
    v = fmaxf(v, dppf(v, v, 0x142, 0xA)); v = fmaxf(v, dppf(v, v, 0x143, 0xC));
    return __builtin_bit_cast(float, __builtin_amdgcn_readlane(__builtin_bit_cast(int, v), 63));
}
__device__ __forceinline__ float siluf(float v) { return v / (1.f + __expf(-v)); }
__device__ __forceinline__ f32x4 mma16(bf16x8 a, bf16x8 b, f32x4 c) { return __builtin_amdgcn_mfma_f32_16x16x32_bf16(a, b, c, 0, 0, 0); }

namespace pg8 {
constexpr int BM = 256, BK = 64, HALF = 128, HTB = HALF * BK * 2, STAGE_BYTES = 8 * HTB;
constexpr int EPI_OFF = 131072, EPI_WAVE = 2304, EPI_P = 144;
__host__ __device__ __forceinline__ int lds_byte(int r, int c) { const int st = (r >> 4) * 2 + (c >> 5), rr = r & 15, cc = c & 31, ob = rr * 64 + cc * 2; return st * 1024 + (ob ^ (((ob >> 9) & 1) << 5)); }
__host__ __device__ __forceinline__ void stage_rc(int b, int& R, int& C) { const int st = b / 1024, sb = b % 1024, swz = sb ^ (((sb >> 9) & 1) << 5); R = (st >> 1) * 16 + swz / 64; C = (st & 1) * 32 + (swz % 64) / 2; }
__host__ __device__ __forceinline__ int perm32(int rho) { const int n = rho >> 4, i = rho & 15; return 8 * (i >> 2) + 4 * n + (i & 3); }

struct Unit { const char* pa; const char* pb; int m0, n0, aux, aux2; };
struct Gemm { int lda, ldb, K; };

__device__ __forceinline__ unsigned cvt_pk_bf16(float lo, float hi) { unsigned r; asm volatile("v_cvt_pk_bf16_f32 %0, %1, %2" : "=v"(r) : "v"(lo), "v"(hi)); return r; }


template <class Epi, class Sched, bool ALIGN_EPI, bool GATHER>
__device__ __forceinline__ void gemm_phase(LAS unsigned char* lds, const Gemm g, const Sched& S, const Epi& E, const int tid) {
    const int wid = __builtin_amdgcn_readfirstlane(tid >> 6), lane = tid & 63, wr = wid >> 2, wc = wid & 3, fr = lane & 15, fq = lane >> 4;
    const int K = g.K, nt = K / BK;
    unsigned voffA[2], voffB[2];
#pragma unroll
    for (int i = 0; i < 2; ++i) { int R, C; stage_rc(tid * 16 + i * 8192, R, C); const int Rb = Epi::PERM ? ((R & ~31) + perm32(R & 31)) : R;
        voffA[i] = GATHER ? 0u : (unsigned)(R * g.lda + C) * 2u; voffB[i] = (unsigned)(Rb * g.ldb + C) * 2u; }
    const size_t kstep = (size_t)(BK * 2);
    const size_t hstepA = (size_t)HALF * g.lda * 2, hstepB = (size_t)HALF * g.ldb * 2;
    const unsigned ldsw = (unsigned)wid * 1024u;
    const int aoff = lds_byte(wr * 64 + fr, fq * 8), boff = lds_byte(wc * 32 + fr, fq * 8);
#define PG8_SA(b, h) (((b) * 2 + (h)) * HTB)
#define PG8_SB(b, h) ((4 + (b) * 2 + (h)) * HTB)
#define PG8_GLDS(src, dstoff) __builtin_amdgcn_global_load_lds((const unsigned*)(src), (LAS unsigned*)(lds + (dstoff)), 16, 0, 0)
#define PG8_STAGE_B(bufoff, gbase, h) do { _Pragma("unroll") for (int _i = 0; _i < 2; ++_i) PG8_GLDS((const char*)(gbase) + (h) * hstepB + voffB[_i], (bufoff) + ldsw + _i * 8192); } while (0)
#define PG8_STAGE_A(bufoff, gbase, h, GV) do { _Pragma("unroll") for (int _i = 0; _i < 2; ++_i) { \
        if constexpr (GATHER) PG8_GLDS((const char*)(gbase) + GV[h][_i], (bufoff) + ldsw + _i * 8192); \
        else PG8_GLDS((const char*)(gbase) + (h) * hstepA + voffA[_i], (bufoff) + ldsw + _i * 8192); } } while (0)
#define PG8_LDA(dst, b, h) do { _Pragma("unroll") for (int m = 0; m < 4; ++m) _Pragma("unroll") for (int k = 0; k < 2; ++k) dst[m][k] = *(const LAS bf16x8*)(lds + PG8_SA(b, h) + aoff + m * 2048 + k * 1024); } while (0)
#define PG8_LDB(dst, b, h) do { _Pragma("unroll") for (int n = 0; n < 2; ++n) _Pragma("unroll") for (int k = 0; k < 2; ++k) dst[n][k] = *(const LAS bf16x8*)(lds + PG8_SB(b, h) + boff + n * 2048 + k * 1024); } while (0)
#define PG8_MMA(ai, bj, At, Bt) do { __builtin_amdgcn_s_setprio(1); _Pragma("unroll") for (int m = 0; m < 4; ++m) _Pragma("unroll") for (int n = 0; n < 2; ++n) _Pragma("unroll") for (int k = 0; k < 2; ++k) \
        acc[ai][bj][m][n] = __builtin_amdgcn_mfma_f32_16x16x32_bf16(Bt[n][k], At[m][k], acc[ai][bj][m][n], 0, 0, 0); __builtin_amdgcn_s_setprio(0); } while (0)
#define PG8_WAIT_V(n) asm volatile("s_waitcnt vmcnt(" #n ")" ::: "memory")
#define PG8_WAIT_L(n) asm volatile("s_waitcnt lgkmcnt(" #n ")" ::: "memory")
#define PG8_BAR __builtin_amdgcn_s_barrier()
#define PG8_SCHED __builtin_amdgcn_sched_barrier(0)
    Unit cur, nxt; int ui = 0;
    if (!S.next(0, cur)) return;
    f32x4 acc[2][2][4][2];
#pragma unroll
    for (int a = 0; a < 2; ++a)
#pragma unroll
        for (int b = 0; b < 2; ++b)
#pragma unroll
            for (int m = 0; m < 4; ++m)
#pragma unroll
                for (int n = 0; n < 2; ++n) acc[a][b][m][n] = (f32x4){0.f, 0.f, 0.f, 0.f};
    bf16x8 At[4][2], B0[2][2], B1[2][2];
    unsigned cvA[2][2], nvA[2][2];
    if constexpr (GATHER) {
#pragma unroll
        for (int h = 0; h < 2; ++h)
#pragma unroll
            for (int i = 0; i < 2; ++i) { int R, C; stage_rc(tid * 16 + i * 8192, R, C); cvA[h][i] = S.row_byteoff(cur, h * HALF + R) + (unsigned)(C * 2); nvA[h][i] = cvA[h][i]; }
    } else { cvA[0][0] = cvA[0][1] = cvA[1][0] = cvA[1][1] = 0u; nvA[0][0] = nvA[0][1] = nvA[1][0] = nvA[1][1] = 0u; }
    const char* cA = cur.pa; const char* cB = cur.pb;
    PG8_STAGE_B(PG8_SB(0, 0), cB, 0); PG8_STAGE_B(PG8_SB(0, 1), cB, 1); PG8_STAGE_A(PG8_SA(0, 0), cA, 0, cvA); PG8_STAGE_A(PG8_SA(0, 1), cA, 1, cvA);
    if (wr == 1) PG8_BAR;
    PG8_WAIT_V(2); PG8_BAR;
    PG8_STAGE_B(PG8_SB(1, 0), cB + kstep, 0); PG8_STAGE_A(PG8_SA(1, 0), cA + kstep, 0, cvA); PG8_STAGE_B(PG8_SB(1, 1), cB + kstep, 1);
    PG8_WAIT_V(6); PG8_BAR;
    for (;;) {
        const bool has_next = S.next(ui + 1, nxt);
        const char* nA = has_next ? nxt.pa : cA; const char* nB = has_next ? nxt.pb : cB;
        if constexpr (GATHER) {
            if (has_next) {
#pragma unroll
                for (int h = 0; h < 2; ++h)
#pragma unroll
                    for (int i = 0; i < 2; ++i) { int R, C; stage_rc(tid * 16 + i * 8192, R, C); nvA[h][i] = S.row_byteoff(nxt, h * HALF + R) + (unsigned)(C * 2); }
            }
        }
        for (int t = 0; t < nt; t += 2) {
            const bool last = (t == nt - 2);
            const char* a1 = cA + (size_t)(t + 1) * kstep;
            const char* a2 = last ? nA : cA + (size_t)(t + 2) * kstep; const char* b2 = last ? nB : cB + (size_t)(t + 2) * kstep;
            const char* a3 = a2 + kstep; const char* b3 = b2 + kstep;
            unsigned v2[2][2];
#pragma unroll
            for (int h = 0; h < 2; ++h)
#pragma unroll
                for (int i = 0; i < 2; ++i) v2[h][i] = last ? nvA[h][i] : cvA[h][i];
            PG8_LDB(B0, 0, 0); PG8_LDB(B1, 0, 1); PG8_SCHED; PG8_LDA(At, 0, 0); PG8_STAGE_A(PG8_SA(1, 1), a1, 1, cvA);
            PG8_WAIT_V(8); PG8_WAIT_L(0); PG8_BAR; PG8_MMA(0, 0, At, B0); PG8_MMA(0, 1, At, B1); PG8_BAR; PG8_SCHED;
            PG8_LDA(At, 0, 1); PG8_STAGE_B(PG8_SB(0, 0), b2, 0); PG8_STAGE_B(PG8_SB(0, 1), b2, 1); PG8_STAGE_A(PG8_SA(0, 0), a2, 0, v2);
            PG8_WAIT_V(8); PG8_WAIT_L(0); PG8_BAR; PG8_MMA(1, 0, At, B0); PG8_MMA(1, 1, At, B1); PG8_BAR; PG8_SCHED;
            PG8_LDB(B0, 1, 0); PG8_LDB(B1, 1, 1); PG8_SCHED; PG8_LDA(At, 1, 0); PG8_STAGE_A(PG8_SA(0, 1), a2, 1, v2);
            PG8_WAIT_V(8); PG8_WAIT_L(0); PG8_BAR; PG8_MMA(0, 0, At, B0); PG8_MMA(0, 1, At, B1); PG8_BAR; PG8_SCHED;
            PG8_LDA(At, 1, 1); PG8_STAGE_B(PG8_SB(1, 0), b3, 0); PG8_STAGE_B(PG8_SB(1, 1), b3, 1); PG8_STAGE_A(PG8_SA(1, 0), a3, 0, v2);
            PG8_WAIT_V(8); PG8_WAIT_L(0); PG8_BAR; PG8_MMA(1, 0, At, B0); PG8_MMA(1, 1, At, B1); PG8_BAR; PG8_SCHED;
        }
        if constexpr (ALIGN_EPI) { if (wr == 0) PG8_BAR; }
        { int tl = tid; asm volatile("" : "+v"(tl));
          E(acc, cur, wr, wc, fr, fq, lds + EPI_OFF + (tl >> 6) * EPI_WAVE, tl & 63); }
        if (!has_next) break;
#pragma unroll
        for (int a = 0; a < 2; ++a)
#pragma unroll
            for (int b = 0; b < 2; ++b)
#pragma unroll
                for (int m = 0; m < 4; ++m)
#pragma unroll
                    for (int n = 0; n < 2; ++n) acc[a][b][m][n] = (f32x4){0.f, 0.f, 0.f, 0.f};
        cur = nxt; cA = nA; cB = nB; ++ui;
        if constexpr (GATHER) {
#pragma unroll
            for (int h = 0; h < 2; ++h)
#pragma unroll
                for (int i = 0; i < 2; ++i) cvA[h][i] = nvA[h][i];
        }
        if constexpr (ALIGN_EPI) { if (wr == 1) PG8_BAR; }
    }
    PG8_WAIT_V(0);
    if constexpr (!ALIGN_EPI) { if (wr == 0) PG8_BAR; }
    PG8_BAR;
#undef PG8_SA
#undef PG8_SB
#undef PG8_GLDS
#undef PG8_STAGE_A
#undef PG8_STAGE_B
#undef PG8_LDA
#undef PG8_LDB
#undef PG8_MMA
#undef PG8_WAIT_V
#undef PG8_WAIT_L
#undef PG8_BAR
#undef PG8_SCHED
}

constexpr int NXCD = 8, WGM = 8;
__device__ __forceinline__ int xcd_remap(long L, int nwg) { int wgid = (int)L; const int q = nwg / NXCD, r = nwg % NXCD, xcd = wgid % NXCD, off = wgid / NXCD; return (xcd < r ? xcd * (q + 1) : r * (q + 1) + (xcd - r) * q) + off; }

struct SchedDense {
    int nM, nN, nwg, G, c; const char* A; const char* B; size_t a_tile, b_tile; int a_cdiv, a_cstride, n_div, n_stride;
    __device__ __forceinline__ void init(int nM_, int nN_, int G_, int c_, const void* A_, size_t a_tile_, const void* B_, size_t b_tile_) {
        nM = nM_; nN = nN_; nwg = nM * nN; G = G_; c = c_; A = (const char*)A_; B = (const char*)B_; a_tile = a_tile_; b_tile = b_tile_; a_cdiv = 1; a_cstride = 0; n_div = 1; n_stride = 256; }
    __device__ __forceinline__ bool next(int i, Unit& u) const {
        const long L = (long)i * G + c; if (L >= nwg) return false;
        const int wgid = xcd_remap(L, nwg);
        const int nig = WGM * nN, gid = wgid / nig, fm = gid * WGM, gsz = (nM - fm) < WGM ? (nM - fm) : WGM;
        const int pm = fm + ((wgid % nig) % gsz), pn = (wgid % nig) / gsz;
        u.pa = A + (size_t)pm * a_tile + (size_t)(pn / a_cdiv) * a_cstride; u.pb = B + (size_t)pn * b_tile;
        u.m0 = pm * BM; u.n0 = (pn / n_div) * n_stride + (pn % n_div) * BM; u.aux = 0; u.aux2 = 0; return true;
    }
};

template <int NPN, bool GATEUP> struct SchedMoe {
    const LAS int* tab; int nwg, G, c; const char* A; const char* W; size_t w_exp, w_tile; const int* rowtok;
    __device__ __forceinline__ void init(const LAS int* tab_, int G_, int c_, const void* A_, const void* W_, size_t w_exp_, size_t w_tile_, const int* rowtok_) {
        tab = tab_; nwg = tab_[32] * NPN; G = G_; c = c_; A = (const char*)A_; W = (const char*)W_; w_exp = w_exp_; w_tile = w_tile_; rowtok = rowtok_; }
    __device__ __forceinline__ bool next(int i, Unit& u) const {
        const long L = (long)i * G + c; if (L >= nwg) return false;
        const int wgid = xcd_remap(L, nwg);
        int e = 0;
#pragma unroll 1
        for (int k = 16; k >= 1; k >>= 1) if (e + k < 32 && tab[e + k] * NPN <= wgid) e += k;
        const int loc = wgid - tab[e] * NPN, nte = tab[e + 1] - tab[e], pn = loc / nte, ti = loc % nte;
        const int rowbase = (tab[e] + ti) * BM;
        u.m0 = rowbase; u.aux = e; u.aux2 = ti * BM;
        if (GATEUP) { u.pa = A; u.pb = W + (size_t)e * w_exp + (size_t)pn * w_tile; u.n0 = pn * 128; }
        else { u.pa = A + (size_t)rowbase * FF * 2; u.pb = W + (size_t)e * w_exp + (size_t)pn * w_tile; u.n0 = pn * BM; }
        return true;
    }
    __device__ __forceinline__ unsigned row_byteoff(const Unit& u, int r) const {
        const int pos = u.aux2 + r; const int cnt = tab[40 + u.aux];
        const int tok = pos < cnt ? rowtok[u.aux * CAP + pos] : 0;
        return (unsigned)tok * (unsigned)(D * 2);
    }
};

__device__ __forceinline__ void epi_tile_bf16(LAS unsigned char* st, const u32x4 w0, const u32x4 w1, bf16* O, const size_t ldc, const int lane, const int fr, const int fq) {
    *(LAS u32x4*)(st + fr * EPI_P + fq * 16) = w0; *(LAS u32x4*)(st + fr * EPI_P + 64 + fq * 16) = w1;
    const int r = lane >> 3, sg = (lane >> 2) & 1, c = lane & 3;
    const u32x4 a = *(const LAS u32x4*)(st + r * EPI_P + sg * 64 + c * 16), b = *(const LAS u32x4*)(st + (r + 8) * EPI_P + sg * 64 + c * 16);
    *(u32x4*)(O + (size_t)r * ldc + sg * HALF + c * 8) = a; *(u32x4*)(O + (size_t)(r + 8) * ldc + sg * HALF + c * 8) = b;
}
struct EpiBf16 {
    static constexpr bool PERM = true;
    bf16* O; int ldc; float scale;
    __device__ __forceinline__ void operator()(const f32x4 (&acc)[2][2][4][2], const Unit& u, int wr, int wc, int fr, int fq, LAS unsigned char* st, int lane) const {
#pragma unroll
        for (int ai = 0; ai < 2; ++ai)
#pragma unroll
            for (int m = 0; m < 4; ++m) { u32x4 w[2];
#pragma unroll
                for (int bj = 0; bj < 2; ++bj) { const f32x4 v0 = acc[ai][bj][m][0] * scale, v1 = acc[ai][bj][m][1] * scale;
                    w[bj].x = cvt_pk_bf16(v0[0], v0[1]); w[bj].y = cvt_pk_bf16(v0[2], v0[3]); w[bj].z = cvt_pk_bf16(v1[0], v1[1]); w[bj].w = cvt_pk_bf16(v1[2], v1[3]); }
                epi_tile_bf16(st, w[0], w[1], O + (size_t)(u.m0 + wr * 64 + ai * HALF + m * 16) * ldc + u.n0 + wc * 32, (size_t)ldc, lane, fr, fq); }
    }
};
struct EpiGateUp {
    static constexpr bool PERM = true;
    bf16* O;
    __device__ __forceinline__ void operator()(const f32x4 (&acc)[2][2][4][2], const Unit& u, int wr, int wc, int fr, int fq, LAS unsigned char* st, int lane) const {
        const int r = lane >> 2, c = lane & 3;
#pragma unroll
        for (int ai = 0; ai < 2; ++ai)
#pragma unroll
            for (int m = 0; m < 4; ++m) {
                f32x4 h0, h1;
#pragma unroll
                for (int k = 0; k < 4; ++k) { h0[k] = siluf(acc[ai][0][m][0][k]) * acc[ai][1][m][0][k]; h1[k] = siluf(acc[ai][0][m][1][k]) * acc[ai][1][m][1][k]; }
                u32x4 w; w.x = cvt_pk_bf16(h0[0], h0[1]); w.y = cvt_pk_bf16(h0[2], h0[3]); w.z = cvt_pk_bf16(h1[0], h1[1]); w.w = cvt_pk_bf16(h1[2], h1[3]);
                *(LAS u32x4*)(st + fr * EPI_P + fq * 16) = w;
                const u32x4 a = *(const LAS u32x4*)(st + r * EPI_P + c * 16);
                *(u32x4*)(O + (size_t)(u.m0 + wr * 64 + ai * HALF + m * 16 + r) * FF + u.n0 + wc * 32 + c * 8) = a; }
    }
};
struct EpiDown {
    static constexpr bool PERM = true;
    bf16* O; const float* rowgate; const LAS int* tab;
    __device__ __forceinline__ void operator()(const f32x4 (&acc)[2][2][4][2], const Unit& u, int wr, int wc, int fr, int fq, LAS unsigned char* st, int lane) const {
        const int rl0 = wr * 64 + fr; const int cnt = tab[40 + u.aux];
#pragma unroll
        for (int ai = 0; ai < 2; ++ai)
#pragma unroll
            for (int m = 0; m < 4; ++m) { const int rl = rl0 + ai * HALF + m * 16, pos = u.aux2 + rl;
                const float gt = pos < cnt ? rowgate[u.aux * CAP + pos] : 0.f;
                u32x4 w[2];
#pragma unroll
                for (int bj = 0; bj < 2; ++bj) { const f32x4 v0 = acc[ai][bj][m][0] * gt, v1 = acc[ai][bj][m][1] * gt;
                    w[bj].x = cvt_pk_bf16(v0[0], v0[1]); w[bj].y = cvt_pk_bf16(v0[2], v0[3]); w[bj].z = cvt_pk_bf16(v1[0], v1[1]); w[bj].w = cvt_pk_bf16(v1[2], v1[3]); }
                epi_tile_bf16(st, w[0], w[1], O + (size_t)(u.m0 + wr * 64 + ai * HALF + m * 16) * D + u.n0 + wc * 32, (size_t)D, lane, fr, fq); }
    }
};
struct EpiRes {
    static constexpr bool PERM = false;
    const bf16* XR; bf16* Hout;
    __device__ __forceinline__ void operator()(const f32x4 (&acc)[2][2][4][2], const Unit& u, int wr, int wc, int fr, int fq, LAS unsigned char* st, int lane) const {
        const int r = lane >> 2, c = lane & 3;
        const size_t off0 = (size_t)(u.m0 + wr * 64 + r) * D + u.n0 + wc * 32 + c * 8;
        u32x4 xr[2][2];
        xr[0][0] = *(const u32x4*)(XR + off0); xr[0][1] = *(const u32x4*)(XR + off0 + HALF);
#pragma unroll
        for (int it = 0; it < 8; ++it) { const int ai = it >> 2, m = it & 3; const size_t off = off0 + (size_t)(ai * HALF + m * 16) * D;
            if (it < 7) { const size_t offn = off0 + (size_t)(((it + 1) >> 2) * HALF + ((it + 1) & 3) * 16) * D; xr[(it + 1) & 1][0] = *(const u32x4*)(XR + offn); xr[(it + 1) & 1][1] = *(const u32x4*)(XR + offn + HALF); }
#pragma unroll
            for (int bj = 0; bj < 2; ++bj) {
                *(LAS f32x4*)(st + fr * EPI_P + fq * 16) = acc[ai][bj][m][0]; *(LAS f32x4*)(st + fr * EPI_P + 64 + fq * 16) = acc[ai][bj][m][1];
                const f32x4 v0 = *(const LAS f32x4*)(st + r * EPI_P + c * 32), v1 = *(const LAS f32x4*)(st + r * EPI_P + c * 32 + 16);
                const u32x4 xw = xr[it & 1][bj];
                u32x4 hw2; hw2.x = cvt_pk_bf16(bflo(xw.x) * ALPHA + v0[0], bfhi(xw.x) * ALPHA + v0[1]); hw2.y = cvt_pk_bf16(bflo(xw.y) * ALPHA + v0[2], bfhi(xw.y) * ALPHA + v0[3]);
                hw2.z = cvt_pk_bf16(bflo(xw.z) * ALPHA + v1[0], bfhi(xw.z) * ALPHA + v1[1]); hw2.w = cvt_pk_bf16(bflo(xw.w) * ALPHA + v1[2], bfhi(xw.w) * ALPHA + v1[3]);
                *(u32x4*)(Hout + off + bj * HALF) = hw2; }
            asm volatile("" ::: "memory"); }
    }
};
struct EpiPle {
    static constexpr bool PERM = false;
    const bf16* XR; float* Xout; bf16* XBout; const bf16* PP; const float* bg;
    __device__ __forceinline__ void operator()(const f32x4 (&acc)[2][2][4][2], const Unit& u, int wr, int wc, int fr, int fq, LAS unsigned char* st, int lane) const {
        const int r = lane >> 2, c = lane & 3;
        const int colb = u.n0 + wc * 32 + c * 8;
        const size_t off0 = (size_t)(u.m0 + wr * 64 + r) * D + colb;
        f32x4 bv[2][2];
#pragma unroll
        for (int bj = 0; bj < 2; ++bj) { bv[bj][0] = *(const f32x4*)(bg + colb + bj * HALF); bv[bj][1] = *(const f32x4*)(bg + colb + bj * HALF + 4); }
        u32x4 xr[2][2], pr[2][2];
        xr[0][0] = *(const u32x4*)(XR + off0); xr[0][1] = *(const u32x4*)(XR + off0 + HALF); pr[0][0] = *(const u32x4*)(PP + off0); pr[0][1] = *(const u32x4*)(PP + off0 + HALF);
#pragma unroll
        for (int it = 0; it < 8; ++it) { const int ai = it >> 2, m = it & 3; const size_t off = off0 + (size_t)(ai * HALF + m * 16) * D;
            if (it < 7) { const size_t offn = off0 + (size_t)(((it + 1) >> 2) * HALF + ((it + 1) & 3) * 16) * D;
                xr[(it + 1) & 1][0] = *(const u32x4*)(XR + offn); xr[(it + 1) & 1][1] = *(const u32x4*)(XR + offn + HALF); pr[(it + 1) & 1][0] = *(const u32x4*)(PP + offn); pr[(it + 1) & 1][1] = *(const u32x4*)(PP + offn + HALF); }
#pragma unroll
            for (int bj = 0; bj < 2; ++bj) {
                *(LAS f32x4*)(st + fr * EPI_P + fq * 16) = acc[ai][bj][m][0]; *(LAS f32x4*)(st + fr * EPI_P + 64 + fq * 16) = acc[ai][bj][m][1];
                const f32x4 a0 = *(const LAS f32x4*)(st + r * EPI_P + c * 32) + bv[bj][0], a1 = *(const LAS f32x4*)(st + r * EPI_P + c * 32 + 16) + bv[bj][1];
                const u32x4 xw = xr[it & 1][bj], pw = pr[it & 1][bj]; f32x4 o0, o1;
                o0[0] = bflo(xw.x) + bflo(pw.x) / (1.f + __expf(-a0[0])); o0[1] = bfhi(xw.x) + bfhi(pw.x) / (1.f + __expf(-a0[1]));
                o0[2] = bflo(xw.y) + bflo(pw.y) / (1.f + __expf(-a0[2])); o0[3] = bfhi(xw.y) + bfhi(pw.y) / (1.f + __expf(-a0[3]));
                o1[0] = bflo(xw.z) + bflo(pw.z) / (1.f + __expf(-a1[0])); o1[1] = bfhi(xw.z) + bfhi(pw.z) / (1.f + __expf(-a1[1]));
                o1[2] = bflo(xw.w) + bflo(pw.w) / (1.f + __expf(-a1[2])); o1[3] = bfhi(xw.w) + bfhi(pw.w) / (1.f + __expf(-a1[3]));
                if (Xout) { *(f32x4*)(Xout + off + bj * HALF) = o0; *(f32x4*)(Xout + off + bj * HALF + 4) = o1; }
                u32x4 w; w.x = cvt_pk_bf16(o0[0], o0[1]); w.y = cvt_pk_bf16(o0[2], o0[3]); w.z = cvt_pk_bf16(o1[0], o1[1]); w.w = cvt_pk_bf16(o1[2], o1[3]);
                *(u32x4*)(XBout + off + bj * HALF) = w; }
            asm volatile("" ::: "memory"); }
    }
};
}

#define XB_TMO      128
#define XB_XCNT(j)  (256  + 64 * (j))
#define XB_XSUB(j)  (1280 + 64 * (j))
#define XB_XGEN(j)  (2304 + 64 * (j))
#define XB_TOP      3328
#define XB_TOPGEN   3392
#define XCD_BAR_WORDS 3456
#define XB_SPIN_CAP (1u << 18)

__device__ __forceinline__ unsigned xb_ld(unsigned* p)              { return __hip_atomic_load(p, __ATOMIC_RELAXED, __HIP_MEMORY_SCOPE_AGENT); }
__device__ __forceinline__ unsigned xb_add(unsigned* p, unsigned v) { return __hip_atomic_fetch_add(p, v, __ATOMIC_RELAXED, __HIP_MEMORY_SCOPE_AGENT); }
__device__ __forceinline__ unsigned xb_xcc_id() { return (unsigned)__builtin_amdgcn_s_getreg((3 << 11) | 20) & 0xFu; }
#define XB_SPIN(cond, bar) do { unsigned _sp = 0; while (cond) { __builtin_amdgcn_s_sleep(1); \
    if ((++_sp & 255u) == 0u) { if (xb_ld(&(bar)[XB_TMO])) break; if (_sp > XB_SPIN_CAP) { atomicAdd(&(bar)[XB_TMO], 1u); break; } } } } while (0)

struct XcdBarrier { unsigned* bar; unsigned x; volatile LAS unsigned* st; };

__device__ __forceinline__ XcdBarrier xcd_barrier_post(unsigned* bar, volatile LAS unsigned* st) {
    XcdBarrier b; b.bar = bar; b.x = xb_xcc_id(); b.st = st;
    if (threadIdx.x == 0) (void)xb_add(&bar[XB_XCNT(b.x)], 1u);
    return b;
}
__device__ __forceinline__ void xcd_barrier_complete(unsigned* bar, unsigned x, unsigned& nloc, unsigned& nx) {
    const unsigned G = gridDim.x * gridDim.y * gridDim.z;
    unsigned sum, cnt, mine, sp = 0u;
    for (;;) {
        sum = 0u; cnt = 0u; mine = 0u;
#pragma unroll
        for (unsigned j = 0; j < 16; ++j) { const unsigned c = xb_ld(&bar[XB_XCNT(j)]); sum += c; cnt += (c > 0u) ? 1u : 0u; mine = (j == x) ? c : mine; }
        if (sum == G) break;
        __builtin_amdgcn_s_sleep(1);
        if ((++sp & 255u) == 0u) { if (xb_ld(&bar[XB_TMO])) break; if (sp > XB_SPIN_CAP) { atomicAdd(&bar[XB_TMO], 1u); break; } }
    }
    nloc = mine > 0u ? mine : 1u; nx = cnt > 0u ? cnt : 1u;
}
__device__ __forceinline__ void xcd_barrier(const XcdBarrier& b) {
    asm volatile("s_waitcnt vmcnt(0)" ::: "memory");
    __syncthreads();
    if (threadIdx.x == 0) {
        unsigned* bar = b.bar;
        __builtin_amdgcn_s_waitcnt(0);
        unsigned nloc = b.st[0], nx = b.st[1];
        if (nloc == 0u) { xcd_barrier_complete(bar, b.x, nloc, nx); b.st[0] = nloc; b.st[1] = nx; }
        const unsigned old = xb_add(&bar[XB_XSUB(b.x)], 1u);
        const unsigned gen = old / nloc;
        if (old + 1u == (gen + 1u) * nloc) {
            __builtin_amdgcn_fence(__ATOMIC_RELEASE, "agent");
            asm volatile("s_waitcnt vmcnt(0)" ::: "memory");
            const unsigned og = xb_add(&bar[XB_TOP], 1u);
            const unsigned tg = og / nx;
            if (og + 1u == (tg + 1u) * nx) xb_add(&bar[XB_TOPGEN], 1u);
            else XB_SPIN(xb_ld(&bar[XB_TOPGEN]) == tg, bar);
            __builtin_amdgcn_fence(__ATOMIC_ACQUIRE, "agent");
            xb_add(&bar[XB_XGEN(b.x)], 1u);
            asm volatile("s_waitcnt vmcnt(0)" ::: "memory");
        } else {
            XB_SPIN(xb_ld(&bar[XB_XGEN(b.x)]) == gen, bar);
            __builtin_amdgcn_fence(__ATOMIC_ACQUIRE, "agent");
            asm volatile("s_waitcnt vmcnt(0)" ::: "memory");
        }
    }
    __syncthreads();
}

struct Frame {
    LAS unsigned char* lds;
    int tid, lane, wave;
    int G, cid, gw, NGW;
    unsigned char* ws;
    const __attribute__((address_space(4))) unsigned char* ka;
};
#define F_CTL ((gu32*)(F.ws + WS_CTL))
#define F_OUT (*(float* const __attribute__((address_space(4)))*)(F.ka + 248))
#define WSP(T_, off) ((T_*)(F.ws + (off)))
#define FIN(k) (*(const float* const __attribute__((address_space(4)))*)(F.ka + 8 * (k)))
#define PHASE_BEGIN() do { asm volatile("" : "+s"(F.ws)); asm volatile("" : "+s"(F.ka)); asm volatile("" : "+s"(F.wave)); asm volatile("" : "+s"(F.G)); asm volatile("" : "+s"(F.cid)); \
    { int z_; asm volatile("s_mov_b32 %0, 0" : "=s"(z_)); F.lane = (int)__builtin_amdgcn_mbcnt_hi(~0u, __builtin_amdgcn_mbcnt_lo(~0u, (unsigned)z_)); } \
    F.tid = F.wave * 64 + F.lane; F.gw = F.cid * 8 + F.wave; F.NGW = F.G * 8; } while (0)

__device__ __forceinline__ void tr_item(const float* W, int ldw, int col0, int nvalid, int k0, bf16* dst, int dst_ld, LAS float* scr, int lane) {
    const int cl = lane & 31;
    { float tv[32]; const float* wp = W + (size_t)(k0 + (lane >> 5)) * ldw + col0 + cl;
#pragma unroll
      for (int i = 0; i < 32; ++i) tv[i] = (cl < nvalid) ? __builtin_nontemporal_load(wp + (size_t)(2 * i) * ldw) : 0.f;
#pragma unroll
      for (int i = 0; i < 32; ++i) scr[(2 * i + (lane >> 5)) * 33 + cl] = tv[i]; }
    LDS_WAIT(); asm volatile("" ::: "memory");
    const int c = lane & 7;
#pragma unroll
    for (int j = 0; j < 4; ++j) { const int n = (lane >> 3) + 8 * j; const LAS float* s = scr + (8 * c) * 33 + n;
        u32x4 o; o.x = pk2(s[0 * 33], s[1 * 33]); o.y = pk2(s[2 * 33], s[3 * 33]); o.z = pk2(s[4 * 33], s[5 * 33]); o.w = pk2(s[6 * 33], s[7 * 33]);
        *(GAS u32x4*)(dst + (size_t)n * dst_ld + 8 * c) = o; }
    LDS_WAIT(); asm volatile("" ::: "memory");
}
__device__ __forceinline__ void zero_item(bf16* dst, int dst_ld, int lane) {
    const int c = lane & 7;
#pragma unroll
    for (int j = 0; j < 4; ++j) { const int n = (lane >> 3) + 8 * j; *(GAS u32x4*)(dst + (size_t)n * dst_ld + 8 * c) = (u32x4){0u, 0u, 0u, 0u}; }
}

constexpr int MOE_ITEMS = 49152, MOE_SEG0 = 8192, MOE_SEG1 = 16384;
__device__ __forceinline__ void moe_cvt(Frame& F, int l, int q, LAS float* scr) {
    const int mat = q >> 14, rr0 = q & 16383, e = rr0 >> 9, rr = rr0 & 511, le = l * 32 + e;
    if (mat < 2) { const int nb = rr % 16, kb = rr / 16;
        const float* W = FIN(mat ? 26 : 25) + (size_t)le * 2048 * 512;
        bf16* dst = WSP(bf16, WS_WGU) + (size_t)le * 1024 * 2048 + (size_t)((nb >> 2) * 256 + (nb & 3) * 32 + mat * 128) * 2048 + kb * 64;
        tr_item(W, 512, nb * 32, 32, kb * 64, dst, 2048, scr, F.lane);
    } else { const int nb = rr % 64, kb = rr / 64;
        const float* W = FIN(27) + (size_t)le * 512 * 2048;
        bf16* dst = WSP(bf16, WS_WD) + (size_t)le * 2048 * 512 + (size_t)(nb * 32) * 512 + kb * 64;
        tr_item(W, 2048, nb * 32, 32, kb * 64, dst, 512, scr, F.lane); }
}
__device__ __forceinline__ void moe_cvt_tail(Frame& F, int nwg, int l, int q0, int q1) {
    const int rem = nwg % F.G; int rank, nr;
    if (rem == 0) { rank = F.cid; nr = F.G; } else { if (F.cid < rem) return; rank = F.cid - rem; nr = F.G - rem; }
    LAS float* scr = (LAS float*)(F.lds + F.wave * 16384);
    for (int q = q0 + rank * 8 + F.wave; q < q1; q += nr * 8) moe_cvt(F, l, q, scr);
}
__device__ __forceinline__ void p0_prologue(Frame& F) {
    LAS float* scr = (LAS float*)(F.lds + F.wave * 16384);
    const int lane = F.lane;
    constexpr int N_EVIN = 2 * 208 * 32, N_EVOUT = 2 * 64 * 48, N_ODIN = 2 * 152 * 32, N_ODOUT = 2 * 64 * 32, N_UK = 2 * 16 * 16 * 2, N_UV = 2 * 16 * 4 * 8;
    constexpr int N_MOE = (MOE_ITEMS - MOE_SEG0) + 3 * (MOE_ITEMS - MOE_SEG1), N_PG = 4 * 64 * 32, N_PPW = 4 * 64 * 4;
    constexpr int NITEMS = N_EVIN + N_EVOUT + N_ODIN + N_ODOUT + N_UK + N_UV + N_MOE + N_PG + N_PPW;
    for (int it = F.gw; it < NITEMS; it += F.NGW) {
        int r = it;
        if (r < N_MOE) {
            constexpr int N0 = MOE_ITEMS - MOE_SEG0, N1 = MOE_ITEMS - MOE_SEG1;
            int l, q; if (r < N0) { l = 0; q = MOE_SEG0 + r; } else { const int r2 = r - N0; l = 1 + r2 / N1; q = MOE_SEG1 + r2 % N1; }
            moe_cvt(F, l, q, scr); continue; }
        r -= N_MOE;
        if (r < N_EVIN) {
            const int j = r / (208 * 32), rr = r % (208 * 32), nb = rr % 208, kb = rr / 208, n0 = nb * 32;
            int src; if (n0 < 5120) src = n0; else if (n0 < 6144) src = n0 - 5120 + 5152; else if (n0 < 6272) src = n0 - 6144 + 6176; else if (n0 < 6400) src = n0 - 6272 + 6304; else if (n0 < 6432) src = 5120 + (n0 - 6400); else src = -1;
            bf16* dst = WSP(bf16, WS_WIN_E) + (size_t)j * EV_INP * 2048 + (size_t)n0 * 2048 + kb * 64;
            if (src < 0) zero_item(dst, 2048, lane); else tr_item(FIN(3) + (size_t)j * 2048 * EV_IN, EV_IN, src, 32, kb * 64, dst, 2048, scr, lane);
            continue; }
        r -= N_EVIN;
        if (r < N_EVOUT) {
            const int j = r / (64 * 48), rr = r % (64 * 48), nb = rr % 64, kb = rr / 64;
            tr_item(FIN(11) + (size_t)j * 3072 * 2048, 2048, nb * 32, 32, kb * 64, WSP(bf16, WS_WOUT_E) + (size_t)j * 2048 * 3072 + (size_t)(nb * 32) * 3072 + kb * 64, 3072, scr, lane); continue; }
        r -= N_EVOUT;
        if (r < N_ODIN) {
            const int j = r / (152 * 32), rr = r % (152 * 32), nb = rr % 152, kb = rr / 152, n0 = nb * 32;
            int src, nv = 32; if (n0 < 3584) src = n0; else if (n0 < 4608) src = n0 - 3584 + 3648; else if (n0 < 4672) src = n0 - 4608 + 3584; else if (n0 < 4736) src = n0; else if (n0 < 4768) { src = 4736; nv = 16; } else src = -1;
            bf16* dst = WSP(bf16, WS_WIN_O) + (size_t)j * OD_INP * 2048 + (size_t)n0 * 2048 + kb * 64;
            if (src < 0) zero_item(dst, 2048, lane); else tr_item(FIN(12) + (size_t)j * 2048 * OD_IN, OD_IN, src, nv, kb * 64, dst, 2048, scr, lane);
            continue; }
        r -= N_ODIN;
        if (r < N_ODOUT) {
            const int j = r / (64 * 32), rr = r % (64 * 32), nb = rr % 64, kb = rr / 64;
            tr_item(FIN(16) + (size_t)j * 2048 * 2048, 2048, nb * 32, 32, kb * 64, WSP(bf16, WS_WOUT_O) + (size_t)j * 2048 * 2048 + (size_t)(nb * 32) * 2048 + kb * 64, 2048, scr, lane); continue; }
        r -= N_ODOUT;
        if (r < N_UK) {
            const int jh = r / 32, rr = r % 32, nb = rr / 2, kb = rr % 2;
            tr_item(FIN(14) + (size_t)jh * 128 * 512, 512, nb * 32, 32, kb * 64, WSP(bf16, WS_WUK) + (size_t)jh * 512 * 128 + (size_t)(nb * 32) * 128 + kb * 64, 128, scr, lane); continue; }
        r -= N_UK;
        if (r < N_UV) {
            const int jh = r / 32, rr = r % 32, nb = rr / 8, kb = rr % 8, h = jh & 15;
            bf16* drow = WSP(bf16, WS_WUV) + (size_t)(jh >> 4) * 2048 * 1024 + (size_t)(h * 128 + nb * 32) * 1024;
            tr_item(FIN(15) + (size_t)jh * 512 * 128, 128, nb * 32, 32, kb * 64, drow + (h & 1) * 512 + kb * 64, 1024, scr, lane);
            zero_item(drow + ((h & 1) ^ 1) * 512 + kb * 64, 1024, lane); continue; }
        r -= N_UV;
        if (r < N_PG) {
            const int l = r / (64 * 32), rr = r % (64 * 32), nb = rr % 64, kb = rr / 64;
            tr_item(FIN(29) + (size_t)l * 2048 * 2048, 2048, nb * 32, 32, kb * 64, WSP(bf16, WS_WPG) + (size_t)l * 2048 * 2048 + (size_t)(nb * 32) * 2048 + kb * 64, 2048, scr, lane); continue; }
        r -= N_PG;
        {
            const int l = r / (64 * 4), rr = r % (64 * 4), nb = rr / 4, kb = rr % 4;
            tr_item(FIN(28) + (size_t)l * 256 * 2048, 2048, nb * 32, 32, kb * 64, WSP(bf16, WS_WPP) + (size_t)l * 2048 * 256 + (size_t)(nb * 32) * 256 + kb * 64, 256, scr, lane); }
    }
    const size_t gt = (size_t)F.gw * 64 + lane, NT = (size_t)F.NGW * 64;
    { const f32x4* xs = (const f32x4*)FIN(0); u32x4* xb = WSP(u32x4, WS_XBN);
      for (size_t i = gt; i < (size_t)T * D / 8; i += NT) { const f32x4 v = xs[2 * i], v2 = xs[2 * i + 1]; u32x4 w; w.x = pk2(v[0], v[1]); w.y = pk2(v[2], v[3]); w.z = pk2(v2[0], v2[1]); w.w = pk2(v2[2], v2[3]); xb[i] = w; } }
    { const f32x4* ps = (const f32x4*)FIN(1); u32x4* pb = WSP(u32x4, WS_PB);
      for (size_t i = gt; i < (size_t)DEPTH * T * 256 / 8; i += NT) { const f32x4 v = ps[2 * i], v2 = ps[2 * i + 1]; u32x4 w; w.x = pk2(v[0], v[1]); w.y = pk2(v[2], v[3]); w.z = pk2(v2[0], v2[1]); w.w = pk2(v2[2], v2[3]); pb[i] = w; } }
    { float* rt = WSP(float, WS_RT);
      for (size_t i = gt; i < (size_t)DEPTH * 36 * D; i += NT) { const int d = (int)(i % D), e = (int)((i / D) % 36), l = (int)(i / ((size_t)36 * D));
          rt[i] = e < 4 ? FIN(21)[((size_t)l * D + d) * 4 + e] : FIN(23)[((size_t)l * D + d) * 32 + (e - 4)]; } }
    { float* cs = WSP(float, WS_COS); float* sn = WSP(float, WS_SIN); const int* pos = (const int*)FIN(2);
      for (size_t i = gt; i < (size_t)T * 32; i += NT) { const int t = (int)(i >> 5), k = (int)(i & 31);
          const float inv = powf(10000.0f, -(float)(2 * k) / 64.0f); const float ang = (float)pos[t] * inv;
          cs[i] = (float)cos((double)ang); sn[i] = (float)sin((double)ang); } }
}

__device__ __forceinline__ float wave_incl_scan(float v, int lane) {
#pragma unroll
    for (int o = 1; o < 64; o <<= 1) { const float t = __shfl_up(v, o); if (lane >= o) v += t; }
    return v;
}
__device__ __forceinline__ void even_conv(Frame& F, int j) {
    const bf16* U = WSP(bf16, WS_U); bf16* XC = WSP(bf16, WS_XC);
    const float* cw = FIN(4) + (size_t)j * 4 * 3072; const float* cb = FIN(5) + (size_t)j * 3072;
    const size_t gt = (size_t)F.gw * 64 + F.lane, NT = (size_t)F.NGW * 64;
    for (size_t idx = gt; idx < (size_t)T * 384; idx += NT) {
        const int t = (int)(idx / 384), c0 = (int)(idx % 384) * 8;
        float a[8];
        { const f32x4 b0 = *(const f32x4*)(cb + c0), b1 = *(const f32x4*)(cb + c0 + 4);
          a[0] = b0[0]; a[1] = b0[1]; a[2] = b0[2]; a[3] = b0[3]; a[4] = b1[0]; a[5] = b1[1]; a[6] = b1[2]; a[7] = b1[3]; }
#pragma unroll
        for (int jj = 0; jj < 4; ++jj) { const int tt = t - 3 + jj;
            if (tt >= 0) { const u32x4 u = *(const u32x4*)(U + (size_t)tt * EV_INP + UE_XBC + c0);
                const f32x4 w0 = *(const f32x4*)(cw + jj * 3072 + c0), w1 = *(const f32x4*)(cw + jj * 3072 + c0 + 4);
                a[0] += w0[0] * bflo(u.x); a[1] += w0[1] * bfhi(u.x); a[2] += w0[2] * bflo(u.y); a[3] += w0[3] * bfhi(u.y);
                a[4] += w1[0] * bflo(u.z); a[5] += w1[1] * bfhi(u.z); a[6] += w1[2] * bflo(u.w); a[7] += w1[3] * bfhi(u.w); } }
        u32x4 o; o.x = pk2(siluf(a[0]), siluf(a[1])); o.y = pk2(siluf(a[2]), siluf(a[3])); o.z = pk2(siluf(a[4]), siluf(a[5])); o.w = pk2(siluf(a[6]), siluf(a[7]));
        *(u32x4*)(XC + (size_t)t * 3072 + c0) = o;
    }
    float* DT = WSP(float, WS_DT); float* ACS = WSP(float, WS_ACS);
    for (int it = F.gw; it < 64 * 32; it += F.NGW) {
        const int c = it >> 5, h = it & 31, t0 = c * 128 + F.lane, t1 = t0 + 64;
        const float A = -__expf(FIN(7)[j * 32 + h]), dtb = FIN(6)[j * 32 + h];
        const float y0 = bf2f(U[(size_t)t0 * EV_INP + UE_DT + h]) + dtb, y1 = bf2f(U[(size_t)t1 * EV_INP + UE_DT + h]) + dtb;
        const float d0 = y0 > 20.f ? y0 : log1pf(__expf(y0)), d1 = y1 > 20.f ? y1 : log1pf(__expf(y1));
        const float s0 = wave_incl_scan(d0 * A, F.lane); const float tot = __shfl(s0, 63); const float s1 = wave_incl_scan(d1 * A, F.lane) + tot;
        DT[(size_t)t0 * 32 + h] = d0; DT[(size_t)t1 * 32 + h] = d1; ACS[(size_t)t0 * 32 + h] = s0; ACS[(size_t)t1 * 32 + h] = s1;
    }
}

__device__ __forceinline__ void even_conv_item(Frame& F, int j, int c, int g) {
    const bf16* U = WSP(bf16, WS_U); bf16* XC = WSP(bf16, WS_XC);
    const float* cw = FIN(4) + (size_t)j * 4 * 3072; const float* cb = FIN(5) + (size_t)j * 3072;
    if (F.tid < 384) {
        const int tb = F.tid / 96, o8 = F.tid % 96;
        const int c0 = o8 < 64 ? g * 512 + o8 * 8 : (o8 < 80 ? 2048 + g * 128 + (o8 - 64) * 8 : 2560 + g * 128 + (o8 - 80) * 8);
        float wt[4][8], bs[8];
        { const f32x4 b0 = *(const f32x4*)(cb + c0), b1 = *(const f32x4*)(cb + c0 + 4);
          bs[0] = b0[0]; bs[1] = b0[1]; bs[2] = b0[2]; bs[3] = b0[3]; bs[4] = b1[0]; bs[5] = b1[1]; bs[6] = b1[2]; bs[7] = b1[3]; }
#pragma unroll
        for (int jj = 0; jj < 4; ++jj) { const f32x4 w0 = *(const f32x4*)(cw + jj * 3072 + c0), w1 = *(const f32x4*)(cw + jj * 3072 + c0 + 4);
            wt[jj][0] = w0[0]; wt[jj][1] = w0[1]; wt[jj][2] = w0[2]; wt[jj][3] = w0[3]; wt[jj][4] = w1[0]; wt[jj][5] = w1[1]; wt[jj][6] = w1[2]; wt[jj][7] = w1[3]; }
        const int tbase = c * 128 + tb * 32;
        const bf16* up = U + (size_t)tbase * EV_INP + UE_XBC + c0; bf16* xp = XC + (size_t)tbase * 3072 + c0;
        const u32x4 zz = (u32x4){0u, 0u, 0u, 0u};
        u32x4 r0 = tbase >= 3 ? *(const u32x4*)(up - 3 * (ptrdiff_t)EV_INP) : zz, r1 = tbase >= 2 ? *(const u32x4*)(up - 2 * (ptrdiff_t)EV_INP) : zz, r2 = tbase >= 1 ? *(const u32x4*)(up - (ptrdiff_t)EV_INP) : zz;
#define CV_OUT(ra, rb, rc, rd, l_) do { float a_[8]; const u32x4 q_[4] = {ra, rb, rc, rd}; \
            _Pragma("unroll") for (int k_ = 0; k_ < 8; ++k_) a_[k_] = bs[k_]; \
            _Pragma("unroll") for (int jj = 0; jj < 4; ++jj) { a_[0] += wt[jj][0] * bflo(q_[jj].x); a_[1] += wt[jj][1] * bfhi(q_[jj].x); a_[2] += wt[jj][2] * bflo(q_[jj].y); a_[3] += wt[jj][3] * bfhi(q_[jj].y); \
                a_[4] += wt[jj][4] * bflo(q_[jj].z); a_[5] += wt[jj][5] * bfhi(q_[jj].z); a_[6] += wt[jj][6] * bflo(q_[jj].w); a_[7] += wt[jj][7] * bfhi(q_[jj].w); } \
            u32x4 o_; o_.x = pk2(siluf(a_[0]), siluf(a_[1])); o_.y = pk2(siluf(a_[2]), siluf(a_[3])); o_.z = pk2(siluf(a_[4]), siluf(a_[5])); o_.w = pk2(siluf(a_[6]), siluf(a_[7])); \
            *(u32x4*)(xp + (size_t)(l_) * 3072) = o_; } while (0)
#pragma unroll 1
        for (int l4 = 0; l4 < 32; l4 += 4) {
            const u32x4 n0 = *(const u32x4*)(up + (size_t)(l4 + 0) * EV_INP), n1 = *(const u32x4*)(up + (size_t)(l4 + 1) * EV_INP), n2 = *(const u32x4*)(up + (size_t)(l4 + 2) * EV_INP), n3 = *(const u32x4*)(up + (size_t)(l4 + 3) * EV_INP);
            CV_OUT(r0, r1, r2, n0, l4 + 0); CV_OUT(r1, r2, n0, n1, l4 + 1); CV_OUT(r2, n0, n1, n2, l4 + 2); CV_OUT(n0, n1, n2, n3, l4 + 3);
            r0 = n1; r1 = n2; r2 = n3;
        }
#undef CV_OUT
    }
    float* DT = WSP(float, WS_DT); float* ACS = WSP(float, WS_ACS);
    { const int h = g * 8 + F.wave, t0 = c * 128 + F.lane, t1 = t0 + 64;
      const float A = -__expf(FIN(7)[j * 32 + h]), dtb = FIN(6)[j * 32 + h];
      const float y0 = bf2f(U[(size_t)t0 * EV_INP + UE_DT + h]) + dtb, y1 = bf2f(U[(size_t)t1 * EV_INP + UE_DT + h]) + dtb;
      const float d0 = y0 > 20.f ? y0 : log1pf(__expf(y0)), d1 = y1 > 20.f ? y1 : log1pf(__expf(y1));
      const float s0 = wave_incl_scan(d0 * A, F.lane); const float tot = __shfl(s0, 63); const float s1 = wave_incl_scan(d1 * A, F.lane) + tot;
      DT[(size_t)t0 * 32 + h] = d0; DT[(size_t)t1 * 32 + h] = d1; ACS[(size_t)t0 * 32 + h] = s0; ACS[(size_t)t1 * 32 + h] = s1; }
}

__device__ __forceinline__ void even_states(Frame& F, int j) {
    const bf16* XC = WSP(bf16, WS_XC); const float* DT = WSP(float, WS_DT); const float* ACS = WSP(float, WS_ACS); float* ST = WSP(float, WS_STATES);
    constexpr int LD = 136;
    LAS bf16* BT = (LAS bf16*)F.lds;
    LAS bf16* XT = (LAS bf16*)(F.lds + 128 * LD * 2);
    const int tid = F.tid, lane = F.lane, w = F.wave, fr = lane & 15, fq = lane >> 4;
    for (int it = F.cid; it < 256; it += F.G) {
        const int c = it >> 2, g = it & 3;
        even_conv_item(F, j, c, g);
        VM_WAIT(); __syncthreads();
        for (int i = tid; i < 128 * 16; i += 512) { const int l = i >> 4, n8 = i & 15;
            const u32x4 v = *(const u32x4*)(XC + (size_t)(c * 128 + l) * 3072 + 2048 + g * 128 + n8 * 8);
            LAS bf16* d = BT + (n8 * 8) * LD + l;
            d[0 * LD] = (bf16)(v.x & 0xffff); d[1 * LD] = (bf16)(v.x >> 16); d[2 * LD] = (bf16)(v.y & 0xffff); d[3 * LD] = (bf16)(v.y >> 16);
            d[4 * LD] = (bf16)(v.z & 0xffff); d[5 * LD] = (bf16)(v.z >> 16); d[6 * LD] = (bf16)(v.w & 0xffff); d[7 * LD] = (bf16)(v.w >> 16); }
#pragma unroll 1
        for (int r = 0; r < 8; ++r) {
            const int h = g * 8 + r;
            __syncthreads();
            const float aend = ACS[(size_t)(c * 128 + 127) * 32 + h];
            for (int i = tid; i < 128 * 8; i += 512) { const int l = i >> 3, p8 = i & 7; const size_t t = (size_t)c * 128 + l;
                const float wgt = DT[t * 32 + h] * __expf(aend - ACS[t * 32 + h]);
                const u32x4 v = *(const u32x4*)(XC + t * 3072 + h * 64 + p8 * 8);
                LAS bf16* d = XT + (p8 * 8) * LD + l;
                d[0 * LD] = (bf16)f2bf(bflo(v.x) * wgt); d[1 * LD] = (bf16)f2bf(bfhi(v.x) * wgt); d[2 * LD] = (bf16)f2bf(bflo(v.y) * wgt); d[3 * LD] = (bf16)f2bf(bfhi(v.y) * wgt);
                d[4 * LD] = (bf16)f2bf(bflo(v.z) * wgt); d[5 * LD] = (bf16)f2bf(bfhi(v.z) * wgt); d[6 * LD] = (bf16)f2bf(bflo(v.w) * wgt); d[7 * LD] = (bf16)f2bf(bfhi(v.w) * wgt); }
            __syncthreads();
            const int pt = w & 3, nt0 = (w >> 2) * 4;
            f32x4 acc[4];
#pragma unroll
            for (int q = 0; q < 4; ++q) acc[q] = (f32x4){0.f, 0.f, 0.f, 0.f};
#pragma unroll
            for (int ks = 0; ks < 4; ++ks) { const bf16x8 a = *(const LAS bf16x8*)(XT + (16 * pt + fr) * LD + 32 * ks + 8 * fq);
#pragma unroll
                for (int q = 0; q < 4; ++q) { const bf16x8 b = *(const LAS bf16x8*)(BT + (16 * (nt0 + q) + fr) * LD + 32 * ks + 8 * fq); acc[q] = mma16(b, a, acc[q]); } }
            float* sp = ST + ((size_t)(c * 32 + h) * 64 + 16 * pt + fr) * 128 + 4 * fq;
#pragma unroll
            for (int q = 0; q < 4; ++q) *(f32x4*)(sp + 16 * (nt0 + q)) = acc[q];
        }
    }
}

__device__ __forceinline__ u32x4 rope8(const u32x4 own, const f32x4 c0, const f32x4 c1, const f32x4 s0, const f32x4 s1, const float sgn, const float scale) {
    u32x4 pt; pt.x = (unsigned)__shfl_xor((int)own.x, 4); pt.y = (unsigned)__shfl_xor((int)own.y, 4); pt.z = (unsigned)__shfl_xor((int)own.z, 4); pt.w = (unsigned)__shfl_xor((int)own.w, 4);
    const float o[8] = {bflo(own.x), bfhi(own.x), bflo(own.y), bfhi(own.y), bflo(own.z), bfhi(own.z), bflo(own.w), bfhi(own.w)};
    const float q[8] = {bflo(pt.x), bfhi(pt.x), bflo(pt.y), bfhi(pt.y), bflo(pt.z), bfhi(pt.z), bflo(pt.w), bfhi(pt.w)};
    const float cc[8] = {c0[0], c0[1], c0[2], c0[3], c1[0], c1[1], c1[2], c1[3]}, ss[8] = {s0[0], s0[1], s0[2], s0[3], s1[0], s1[1], s1[2], s1[3]};
    float r[8];
#pragma unroll
    for (int e = 0; e < 8; ++e) r[e] = (o[e] * cc[e] + sgn * (q[e] * ss[e])) * scale;
    return (u32x4){pk2(r[0], r[1]), pk2(r[2], r[3]), pk2(r[4], r[5]), pk2(r[6], r[7])};
}
__device__ __forceinline__ void even_swa(Frame& F, int j) {
    const bf16* U = WSP(bf16, WS_U); bf16* YM = WSP(bf16, WS_YMIX); const float* COS = WSP(float, WS_COS); const float* SIN = WSP(float, WS_SIN);
    constexpr int LK = 72, LV = 216, LP = 168;
    LAS bf16* KS = (LAS bf16*)F.lds;
    LAS bf16* VT = (LAS bf16*)(F.lds + 192 * LK * 2);
    LAS bf16* PW = (LAS bf16*)(F.lds + 192 * LK * 2 + 64 * LV * 2) + F.wave * 16 * LP;
    const int tid = F.tid, lane = F.lane, w = F.wave, fr = lane & 15, fq = lane >> 4;
    for (int it = F.cid; it < 256; it += F.G) {
        const int qb = it >> 1, kvh = it & 1, ws0 = qb * 64 - 128;
        __syncthreads();
        for (int i = tid; i < 192 * 4; i += 512) { const int kw = i >> 2, d8 = i & 3, ka = ws0 + kw;
            u32x4 o1 = (u32x4){0u, 0u, 0u, 0u}, o2 = o1;
            if (ka >= 0) { const bf16* kp = U + (size_t)ka * EV_INP + UE_K + kvh * 64 + d8 * 8;
                const u32x4 v1 = *(const u32x4*)kp, v2 = *(const u32x4*)(kp + 32);
                const f32x4 c0 = *(const f32x4*)(COS + (size_t)ka * 32 + d8 * 8), c1 = *(const f32x4*)(COS + (size_t)ka * 32 + d8 * 8 + 4);
                const f32x4 s0 = *(const f32x4*)(SIN + (size_t)ka * 32 + d8 * 8), s1 = *(const f32x4*)(SIN + (size_t)ka * 32 + d8 * 8 + 4);
                const float t1[8] = {bflo(v1.x), bfhi(v1.x), bflo(v1.y), bfhi(v1.y), bflo(v1.z), bfhi(v1.z), bflo(v1.w), bfhi(v1.w)};
                const float t2[8] = {bflo(v2.x), bfhi(v2.x), bflo(v2.y), bfhi(v2.y), bflo(v2.z), bfhi(v2.z), bflo(v2.w), bfhi(v2.w)};
                const float cc[8] = {c0[0], c0[1], c0[2], c0[3], c1[0], c1[1], c1[2], c1[3]}, ss[8] = {s0[0], s0[1], s0[2], s0[3], s1[0], s1[1], s1[2], s1[3]};
                float r1[8], r2[8];
#pragma unroll
                for (int k = 0; k < 8; ++k) { r1[k] = t1[k] * cc[k] - t2[k] * ss[k]; r2[k] = t2[k] * cc[k] + t1[k] * ss[k]; }
                o1 = (u32x4){pk2(r1[0], r1[1]), pk2(r1[2], r1[3]), pk2(r1[4], r1[5]), pk2(r1[6], r1[7])};
                o2 = (u32x4){pk2(r2[0], r2[1]), pk2(r2[2], r2[3]), pk2(r2[4], r2[5]), pk2(r2[6], r2[7])}; }
            *(LAS u32x4*)(KS + kw * LK + d8 * 8) = o1; *(LAS u32x4*)(KS + kw * LK + 32 + d8 * 8) = o2; }
        for (int i = tid; i < 208 * 8; i += 512) { const int kw = i >> 3, d8 = i & 7, ka = ws0 + kw;
            u32x4 v = (u32x4){0u, 0u, 0u, 0u};
            if (kw < 192 && ka >= 0) v = *(const u32x4*)(U + (size_t)ka * EV_INP + UE_V + kvh * 64 + d8 * 8);
            LAS bf16* d = VT + (d8 * 8) * LV + kw;
            d[0 * LV] = (bf16)(v.x & 0xffff); d[1 * LV] = (bf16)(v.x >> 16); d[2 * LV] = (bf16)(v.y & 0xffff); d[3 * LV] = (bf16)(v.y >> 16);
            d[4 * LV] = (bf16)(v.z & 0xffff); d[5 * LV] = (bf16)(v.z >> 16); d[6 * LV] = (bf16)(v.w & 0xffff); d[7 * LV] = (bf16)(v.w >> 16); }
        __syncthreads();
        const int hq = kvh * 8 + w;
        const float sink2 = FIN(10)[j * 16 + hq] * LOG2E;
#pragma unroll 1
        for (int hf = 0; hf < 2; ++hf) {
          bf16x8 qa[2][2];
          { LAS unsigned char* qs = (LAS unsigned char*)PW;
#pragma unroll
            for (int k = 0; k < 4; ++k) { const int row = 8 * k + (lane >> 3), c = lane & 7, tq = qb * 64 + 32 * hf + row;
                const u32x4 own = *(const u32x4*)(U + (size_t)tq * EV_INP + UE_Q + hq * 64 + c * 8);
                const float* cp = COS + (size_t)tq * 32 + (c & 3) * 8; const float* sp = SIN + (size_t)tq * 32 + (c & 3) * 8;
                const u32x4 rq = rope8(own, *(const f32x4*)cp, *(const f32x4*)(cp + 4), *(const f32x4*)sp, *(const f32x4*)(sp + 4), (c & 4) ? 1.f : -1.f, SWA_QSCALE);
                *(LAS u32x4*)(qs + row * 144 + c * 16) = rq; }
#pragma unroll
            for (int q2 = 0; q2 < 2; ++q2) { qa[q2][0] = *(const LAS bf16x8*)(qs + (16 * q2 + fr) * 144 + fq * 16); qa[q2][1] = *(const LAS bf16x8*)(qs + (16 * q2 + fr) * 144 + 64 + fq * 16); }
            LDS_WAIT(); }
#pragma unroll
          for (int q2 = 0; q2 < 2; ++q2) {
            const int qt = 2 * hf + q2;
            const bf16x8 a0 = qa[q2][0], a1 = qa[q2][1];
            f32x4 s[9];
#pragma unroll
            for (int kk = 0; kk < 9; ++kk) { const int kt = qt + kk;
                const bf16x8 b0 = *(const LAS bf16x8*)(KS + (16 * kt + fr) * LK + 8 * fq), b1 = *(const LAS bf16x8*)(KS + (16 * kt + fr) * LK + 32 + 8 * fq);
                f32x4 z = (f32x4){0.f, 0.f, 0.f, 0.f}; z = mma16(a0, b0, z); s[kk] = mma16(a1, b1, z); }
            float mx[4], sm[4];
#pragma unroll
            for (int i = 0; i < 4; ++i) { const int tq = qb * 64 + 16 * qt + 4 * fq + i; float m = -INFINITY;
#pragma unroll
                for (int kk = 0; kk < 9; ++kk) { const int ka = ws0 + 16 * (qt + kk) + fr; const bool ok = (ka >= 0) && (ka <= tq) && (tq - ka < 128);
                    s[kk][i] = ok ? s[kk][i] : -INFINITY; m = fmaxf(m, s[kk][i]); }
                m = fmaxf(grp16_max(m), sink2); mx[i] = m; float e = 0.f;
#pragma unroll
                for (int kk = 0; kk < 9; ++kk) { const float p = exp2f(s[kk][i] - m); s[kk][i] = p; e += p; }
                sm[i] = 1.f / (grp16_sum(e) + exp2f(sink2 - m)); }
#pragma unroll
            for (int i = 0; i < 4; ++i) {
#pragma unroll
                for (int kk = 0; kk < 9; ++kk) PW[(4 * fq + i) * LP + 16 * kk + fr] = (bf16)f2bf(s[kk][i] * sm[i]);
                PW[(4 * fq + i) * LP + 144 + fr] = (bf16)0; }
            LDS_WAIT();
            f32x4 o[4];
#pragma unroll
            for (int dt = 0; dt < 4; ++dt) o[dt] = (f32x4){0.f, 0.f, 0.f, 0.f};
#pragma unroll
            for (int ks = 0; ks < 5; ++ks) { const bf16x8 a = *(const LAS bf16x8*)(PW + fr * LP + 32 * ks + 8 * fq);
#pragma unroll
                for (int dt = 0; dt < 4; ++dt) { const bf16x8 b = *(const LAS bf16x8*)(VT + (16 * dt + fr) * LV + 16 * qt + 32 * ks + 8 * fq); o[dt] = mma16(a, b, o[dt]); } }
            LDS_WAIT();
#pragma unroll
            for (int i = 0; i < 4; ++i)
#pragma unroll
                for (int dt = 0; dt < 4; ++dt) PW[(4 * fq + i) * 72 + 16 * dt + fr] = (bf16)f2bf(o[dt][i]);
#pragma unroll
            for (int k = 0; k < 2; ++k) { const int row = 8 * k + (lane >> 3), c8 = lane & 7;
                const u32x4 ov = *(const LAS u32x4*)((LAS unsigned char*)PW + row * 144 + c8 * 16);
                *(u32x4*)(YM + (size_t)(qb * 64 + 16 * qt + row) * 3072 + 2048 + hq * 64 + c8 * 8) = ov; }
            LDS_WAIT();
          }
        }
    }
}

__device__ __forceinline__ void even_scan(Frame& F) {
    const f32x4* ST = WSP(f32x4, WS_STATES); u32x2* PV = WSP(u32x2, WS_PREVB); const float* ACS = WSP(float, WS_ACS);
    if (F.wave >= 4) return;
    const size_t gt = (size_t)(F.cid * 4 + F.wave) * 64 + F.lane, NT = (size_t)F.G * 4 * 64;
    for (size_t e4 = gt; e4 < 65536; e4 += NT) {
        const int h = (int)(e4 >> 11); f32x4 hs = (f32x4){0.f, 0.f, 0.f, 0.f};
#pragma unroll 8
        for (int c = 0; c < 64; ++c) { const float dec = __expf(ACS[(size_t)(c * 128 + 127) * 32 + h]); const f32x4 st = ST[(size_t)c * 65536 + e4];
            PV[(size_t)c * 65536 + e4] = (u32x2){pk2(hs[0], hs[1]), pk2(hs[2], hs[3])}; hs = hs * dec + st; }
    }
}

__device__ __forceinline__ void even_y(Frame& F, int j) {
    const bf16* XC = WSP(bf16, WS_XC); const bf16* U = WSP(bf16, WS_U); const float* DT = WSP(float, WS_DT); const float* ACS = WSP(float, WS_ACS);
    const bf16* PV = WSP(bf16, WS_PREVB); bf16* YM = WSP(bf16, WS_YMIX); float* YF = WSP(float, WS_H);
    constexpr int LD = 136;
    LAS bf16* CS = (LAS bf16*)F.lds;
    LAS bf16* BS = (LAS bf16*)(F.lds + 34816);
    LAS bf16* XT = (LAS bf16*)(F.lds + 69632);
    LAS bf16* MW = (LAS bf16*)(F.lds + 87040) + F.wave * 16 * LD;
    LAS float* AL = (LAS float*)(F.lds + 121856);
    LAS float* DL = (LAS float*)(F.lds + 125952);
    LAS bf16* PS = (LAS bf16*)(F.lds + 130048);
    const int tid = F.tid, lane = F.lane, w = F.wave, fr = lane & 15, fq = lane >> 4;
    for (int it = F.cid; it < 256; it += F.G) {
        const int c = it >> 2, g = it & 3;
        u32x4 xr0, xr1, pr0, pr1;
#define Y_FETCH(r_) do { const int h_ = g * 8 + (r_); const bf16* pv_ = PV + (size_t)(c * 32 + h_) * 64 * 128; \
            xr0 = *(const u32x4*)(XC + (size_t)(c * 128 + (tid >> 3)) * 3072 + h_ * 64 + (tid & 7) * 8); xr1 = *(const u32x4*)(XC + (size_t)(c * 128 + 64 + (tid >> 3)) * 3072 + h_ * 64 + (tid & 7) * 8); \
            pr0 = *(const u32x4*)(pv_ + (size_t)(tid >> 4) * 128 + (tid & 15) * 8); pr1 = *(const u32x4*)(pv_ + (size_t)(32 + (tid >> 4)) * 128 + (tid & 15) * 8); } while (0)
        Y_FETCH(0);
        __syncthreads();
        for (int i = tid; i < 128 * 16; i += 512) { const int l = i >> 4, n8 = i & 15; const bf16* src = XC + (size_t)(c * 128 + l) * 3072 + g * 128 + n8 * 8;
            *(LAS u32x4*)(BS + l * LD + n8 * 8) = *(const u32x4*)(src + 2048); *(LAS u32x4*)(CS + l * LD + n8 * 8) = *(const u32x4*)(src + 2560); }
        for (int i = tid; i < 128 * 8; i += 512) { const int l = i >> 3, r = i & 7; AL[i] = ACS[(size_t)(c * 128 + l) * 32 + g * 8 + r]; DL[i] = DT[(size_t)(c * 128 + l) * 32 + g * 8 + r]; }
        __syncthreads();
        f32x4 cb[8];
#pragma unroll
        for (int st = 0; st < 8; ++st) cb[st] = (f32x4){0.f, 0.f, 0.f, 0.f};
#pragma unroll
        for (int ks = 0; ks < 4; ++ks) { const bf16x8 a = *(const LAS bf16x8*)(CS + (16 * w + fr) * LD + 32 * ks + 8 * fq);
#pragma unroll
            for (int st = 0; st < 8; ++st) { const bf16x8 b = *(const LAS bf16x8*)(BS + (16 * st + fr) * LD + 32 * ks + 8 * fq); cb[st] = mma16(a, b, cb[st]); } }
        float ssq[4] = {0.f, 0.f, 0.f, 0.f};
#pragma unroll 1
        for (int r = 0; r < 8; ++r) {
            const int h = g * 8 + r;
            __syncthreads();
#pragma unroll
            for (int k = 0; k < 2; ++k) { const int s = 64 * k + (tid >> 3), p8 = tid & 7; const float wgt = DL[s * 8 + r]; const u32x4 v = k ? xr1 : xr0;
                LAS bf16* d = XT + (p8 * 8) * LD + s;
                d[0 * LD] = (bf16)f2bf(bflo(v.x) * wgt); d[1 * LD] = (bf16)f2bf(bfhi(v.x) * wgt); d[2 * LD] = (bf16)f2bf(bflo(v.y) * wgt); d[3 * LD] = (bf16)f2bf(bfhi(v.y) * wgt);
                d[4 * LD] = (bf16)f2bf(bflo(v.z) * wgt); d[5 * LD] = (bf16)f2bf(bfhi(v.z) * wgt); d[6 * LD] = (bf16)f2bf(bflo(v.w) * wgt); d[7 * LD] = (bf16)f2bf(bfhi(v.w) * wgt); }
            *(LAS u32x4*)(PS + (tid >> 4) * LD + (tid & 15) * 8) = pr0; *(LAS u32x4*)(PS + (32 + (tid >> 4)) * LD + (tid & 15) * 8) = pr1;
            __syncthreads();
            if (r < 7) Y_FETCH(r + 1);
            f32x4 acc[4];
#pragma unroll
            for (int pt = 0; pt < 4; ++pt) acc[pt] = (f32x4){0.f, 0.f, 0.f, 0.f};
#pragma unroll
            for (int ks = 0; ks < 4; ++ks) { const bf16x8 a = *(const LAS bf16x8*)(CS + (16 * w + fr) * LD + 32 * ks + 8 * fq);
#pragma unroll
                for (int pt = 0; pt < 4; ++pt) { const bf16x8 b = *(const LAS bf16x8*)(PS + (16 * pt + fr) * LD + 32 * ks + 8 * fq); acc[pt] = mma16(a, b, acc[pt]); } }
            float al[4];
#pragma unroll
            for (int i = 0; i < 4; ++i) { al[i] = AL[(16 * w + 4 * fq + i) * 8 + r]; const float e = __expf(al[i]);
#pragma unroll
                for (int pt = 0; pt < 4; ++pt) acc[pt][i] *= e; }
#pragma unroll
            for (int st = 0; st < 8; ++st) { const int s = 16 * st + fr; const float as = AL[s * 8 + r];
#pragma unroll
                for (int i = 0; i < 4; ++i) { const int l = 16 * w + 4 * fq + i; const float mv = (s <= l) ? cb[st][i] * __expf(al[i] - as) : 0.f;
                    MW[(4 * fq + i) * LD + s] = (bf16)f2bf(mv); } }
            LDS_WAIT();
#pragma unroll
            for (int ks = 0; ks < 4; ++ks) { const bf16x8 a = *(const LAS bf16x8*)(MW + fr * LD + 32 * ks + 8 * fq);
#pragma unroll
                for (int pt = 0; pt < 4; ++pt) { const bf16x8 b = *(const LAS bf16x8*)(XT + (16 * pt + fr) * LD + 32 * ks + 8 * fq); acc[pt] = mma16(a, b, acc[pt]); } }
            LDS_WAIT();
            const float dsk = FIN(8)[j * 32 + h];
#pragma unroll
            for (int i = 0; i < 4; ++i) { const size_t t = (size_t)c * 128 + 16 * w + 4 * fq + i;
#pragma unroll
                for (int pt = 0; pt < 4; ++pt) { const int col = h * 64 + 16 * pt + fr;
                    const float xv = bf2f(XC[t * 3072 + col]), zv = bf2f(U[t * EV_INP + UE_Z + col]);
                    const float yy = (acc[pt][i] + xv * dsk) * siluf(zv); ssq[i] += yy * yy; YF[t * D + col] = yy; } }
        }
        VM_WAIT();
        const float* nw = FIN(9) + (size_t)j * 2048 + g * 512;
#pragma unroll
        for (int i = 0; i < 4; ++i) {
            const float rstd = rsqrtf(grp16_sum(ssq[i]) * (1.f / 512.f) + LN_EPS);
            const size_t t = (size_t)c * 128 + 16 * w + 4 * fq + i;
            bf16* op = YM + t * 3072 + g * 512 + fr; const float* yp = YF + t * D + g * 512 + fr;
#pragma unroll 4
            for (int q = 0; q < 32; ++q) op[16 * q] = (bf16)f2bf(yp[16 * q] * rstd * nw[16 * q + fr]); }
    }
#undef Y_FETCH
}

struct PrepRaw { u32x4 ckv, qi[2], qr[2], kk; f32x4 c0, c1, s0, s1; unsigned wi; };
__device__ __forceinline__ void prep_load(const bf16* U, const float* COS, const float* SIN, const int t, const int lane, PrepRaw& R) {
    const bf16* u = U + (size_t)t * OD_INP;
    R.ckv = *(const u32x4*)(u + UO_CKV + lane * 8);
    const float* cp = COS + (size_t)t * 32 + (lane & 3) * 8; const float* sp = SIN + (size_t)t * 32 + (lane & 3) * 8;
    R.c0 = *(const f32x4*)cp; R.c1 = *(const f32x4*)(cp + 4); R.s0 = *(const f32x4*)sp; R.s1 = *(const f32x4*)(sp + 4);
    R.kk = *(const u32x4*)(u + UO_KR + (lane & 15) * 8);
    R.wi = u[UO_WI + (lane & 15)];
#pragma unroll
    for (int k = 0; k < 2; ++k) { const int c = lane + 64 * k, h = c >> 3, ch = c & 7;
        R.qi[k] = *(const u32x4*)(u + UO_QI + c * 8); R.qr[k] = *(const u32x4*)(u + UO_Q + h * 192 + 128 + ch * 8); }
}
__device__ __forceinline__ u32x4 rope_chunk(const u32x4 own, const PrepRaw& R, const float sgn, const float scale) {
    u32x4 pt; pt.x = (unsigned)__shfl_xor((int)own.x, 4); pt.y = (unsigned)__shfl_xor((int)own.y, 4); pt.z = (unsigned)__shfl_xor((int)own.z, 4); pt.w = (unsigned)__shfl_xor((int)own.w, 4);
    const float o[8] = {bflo(own.x), bfhi(own.x), bflo(own.y), bfhi(own.y), bflo(own.z), bfhi(own.z), bflo(own.w), bfhi(own.w)};
    const float q[8] = {bflo(pt.x), bfhi(pt.x), bflo(pt.y), bfhi(pt.y), bflo(pt.z), bfhi(pt.z), bflo(pt.w), bfhi(pt.w)};
    const float cc[8] = {R.c0[0], R.c0[1], R.c0[2], R.c0[3], R.c1[0], R.c1[1], R.c1[2], R.c1[3]}, ss[8] = {R.s0[0], R.s0[1], R.s0[2], R.s0[3], R.s1[0], R.s1[1], R.s1[2], R.s1[3]};
    float r[8];
#pragma unroll
    for (int e = 0; e < 8; ++e) r[e] = (o[e] * cc[e] + sgn * (q[e] * ss[e])) * scale;
    return (u32x4){pk2(r[0], r[1]), pk2(r[2], r[3]), pk2(r[4], r[5]), pk2(r[6], r[7])};
}
__device__ __forceinline__ void prep_finish(bf16* KV, bf16* QI, bf16* KI, float* WI, bf16* QL, const f32x4 g0, const f32x4 g1, const int t, const int lane, const PrepRaw& R) {
    const float sgn = (lane & 4) ? 1.f : -1.f;
    { const u32x4 v = R.ckv;
      float x[8] = {bflo(v.x), bfhi(v.x), bflo(v.y), bfhi(v.y), bflo(v.z), bfhi(v.z), bflo(v.w), bfhi(v.w)}; float ss = 0.f;
#pragma unroll
      for (int k = 0; k < 8; ++k) ss += x[k] * x[k];
      const float rstd = rsqrtf(wave_sum(ss) * (1.f / 512.f) + LN_EPS);
      u32x4 o; o.x = pk2(x[0] * rstd * g0[0], x[1] * rstd * g0[1]); o.y = pk2(x[2] * rstd * g0[2], x[3] * rstd * g0[3]);
      o.z = pk2(x[4] * rstd * g1[0], x[5] * rstd * g1[1]); o.w = pk2(x[6] * rstd * g1[2], x[7] * rstd * g1[3]);
      *(u32x4*)(KV + (size_t)t * 576 + lane * 8) = o; }
    { const u32x4 o = rope_chunk(R.kk, R, sgn, 1.f);
      bf16* dst = (lane & 8) ? KI + (size_t)t * 64 + (lane & 7) * 8 : KV + (size_t)t * 576 + 512 + (lane & 7) * 8;
      if (lane < 16) *(u32x4*)dst = o; }
    if (lane < 16) WI[(size_t)t * 16 + lane] = bf2f((unsigned short)R.wi) * 0.03125f;
#pragma unroll
    for (int k = 0; k < 2; ++k) { const int c = lane + 64 * k, h = c >> 3, ch = c & 7;
        *(u32x4*)(QI + (size_t)t * 1024 + c * 8) = rope_chunk(R.qi[k], R, sgn, 1.f);
        *(u32x4*)(QL + (size_t)t * QLD + h * 576 + 512 + ch * 8) = rope_chunk(R.qr[k], R, sgn, MLA_QSCALE); }
}
__device__ __forceinline__ void odd_prep(Frame& F, int j) {
    const bf16* U = WSP(bf16, WS_U); bf16* KV = WSP(bf16, WS_KV); bf16* QI = WSP(bf16, WS_QI); bf16* KI = WSP(bf16, WS_KI); float* WI = WSP(float, WS_WI); bf16* QL = WSP(bf16, WS_QL);
    const float* COS = WSP(float, WS_COS); const float* SIN = WSP(float, WS_SIN); const float* kvn = FIN(13) + (size_t)j * 512;
    const int lane = F.lane;
    const f32x4 g0 = *(const f32x4*)(kvn + lane * 8), g1 = *(const f32x4*)(kvn + lane * 8 + 4);
    for (int t = F.gw; t < T; t += 2 * F.NGW) {
        const int tb = t + F.NGW;
        int ln = lane; asm volatile("" : "+v"(ln));
        PrepRaw A, B;
        prep_load(U, COS, SIN, t, ln, A);
        prep_load(U, COS, SIN, tb < T ? tb : t, ln, B);
        prep_finish(KV, QI, KI, WI, QL, g0, g1, t, ln, A);
        if (tb < T) prep_finish(KV, QI, KI, WI, QL, g0, g1, tb, ln, B);
    }
}
__device__ __forceinline__ float relu1(float v) { const int b = __builtin_bit_cast(int, v); return __builtin_bit_cast(float, b > 0 ? b : 0); }
__device__ __forceinline__ void sc_unit(const int u, int& qt, int& kt) {
    qt = (int)((sqrtf(8.f * (float)u + 1.f) - 1.f) * 0.5f);
    while (qt * (qt + 1) / 2 > u) --qt;
    while ((qt + 1) * (qt + 2) / 2 <= u) ++qt;
    kt = u - qt * (qt + 1) / 2;
}
__device__ __forceinline__ void odd_scores(Frame& F) {
    const bf16* QI = WSP(bf16, WS_QI); const bf16* KI = WSP(bf16, WS_KI); const float* WI = WSP(float, WS_WI); float* S = WSP(float, WS_S);
    const int lane = F.lane, w = F.wave, fr = lane & 15, fq = lane >> 4;
    int u = F.cid; if (u >= 2080) return;
    LAS unsigned char* qb = F.lds + w * 8192;
    LAS unsigned char* kb = F.lds + 65536;
    const int o0 = fr * 128 + ((fq ^ ((fr >> 1) & 7)) * 16);
    const int lr = lane >> 3, lp = lane & 7;
    const int c0 = lp ^ (lr >> 1), c1 = lp ^ (4 + (lr >> 1));
    int qt, kt; sc_unit(u, qt, kt);
    {
        const bf16* kp = KI + (size_t)(kt * 128 + 16 * w + lr) * 64;
        const u32x4 k0 = *(const u32x4*)(kp + c0 * 8), k1 = *(const u32x4*)(kp + 8 * 64 + c1 * 8);
        *(LAS u32x4*)(kb + (16 * w) * 128 + lane * 16) = k0; *(LAS u32x4*)(kb + (16 * w + 8) * 128 + lane * 16) = k1;
    }
    const bf16* qa0 = QI + (size_t)(qt * 128 + 16 * w + lr) * 1024 + c0 * 8;
    const bf16* qa1 = QI + (size_t)(qt * 128 + 16 * w + 8 + lr) * 1024 + c1 * 8;
#define SC_DMA(buf, h0, p0, p1) do { _Pragma("unroll") for (int q_ = 0; q_ < 2; ++q_) { \
        __builtin_amdgcn_global_load_lds((const unsigned*)((p0) + ((h0) + q_) * 64), (LAS unsigned*)(qb + (buf) * 4096 + q_ * 2048), 16, 0, 0); \
        __builtin_amdgcn_global_load_lds((const unsigned*)((p1) + ((h0) + q_) * 64), (LAS unsigned*)(qb + (buf) * 4096 + q_ * 2048 + 1024), 16, 0, 0); } } while (0)
#define SC_FRAG(buf) do { _Pragma("unroll") for (int q_ = 0; q_ < 2; ++q_) { af[buf][q_][0] = *(LAS bf16x8*)(qb + (buf) * 4096 + q_ * 2048 + o0); af[buf][q_][1] = *(LAS bf16x8*)(qb + (buf) * 4096 + q_ * 2048 + (o0 ^ 64)); } } while (0)
    SC_DMA(0, 0, qa0, qa1); SC_DMA(1, 2, qa0, qa1);
    f32x4 wv[4], wn[4]; u32x4 kn0, kn1;
#pragma unroll
    for (int i = 0; i < 4; ++i) wv[i] = *(const f32x4*)(WI + (size_t)(qt * 128 + 16 * w + fr) * 16 + 4 * i);
    VM_WAIT(); LDS_WAIT(); __syncthreads();
    bf16x8 kf[8][2], af[2][2][2];
#pragma unroll
    for (int st = 0; st < 8; ++st) { kf[st][0] = *(LAS bf16x8*)(kb + st * 2048 + o0); kf[st][1] = *(LAS bf16x8*)(kb + st * 2048 + (o0 ^ 64)); }
    SC_FRAG(0);
    int par = 0;
#pragma unroll 1
    while (true) {
        const int un = u + F.G; const bool more = un < 2080; int qtn = qt, ktn = kt; if (more) sc_unit(un, qtn, ktn);
        const bf16* qn0 = QI + (size_t)(qtn * 128 + 16 * w + lr) * 1024 + c0 * 8;
        const bf16* qn1 = QI + (size_t)(qtn * 128 + 16 * w + 8 + lr) * 1024 + c1 * 8;
        f32x4 sc[8];
#pragma unroll
        for (int st = 0; st < 8; ++st) sc[st] = (f32x4){0.f, 0.f, 0.f, 0.f};
#pragma unroll
        for (int hg = 0; hg < 8; ++hg) {
            if (hg == 0) asm volatile("s_waitcnt vmcnt(8)" ::: "memory"); else asm volatile("s_waitcnt vmcnt(0)" ::: "memory");
            SC_FRAG((hg + 1) & 1);
            LDS_WAIT();
            if (hg < 6) SC_DMA(hg & 1, 2 * (hg + 2), qa0, qa1); else SC_DMA(hg & 1, 2 * (hg - 6), qn0, qn1);
            if (hg == 2) {
                const bf16* kp = KI + (size_t)(ktn * 128 + 16 * w + lr) * 64;
                kn0 = *(const u32x4*)(kp + c0 * 8); kn1 = *(const u32x4*)(kp + 8 * 64 + c1 * 8);
#pragma unroll
                for (int i = 0; i < 4; ++i) wn[i] = *(const f32x4*)(WI + (size_t)(qtn * 128 + 16 * w + fr) * 16 + 4 * i);
            }
            __builtin_amdgcn_sched_barrier(0);
            f32x4 zc, zn;
#define SC_MMA(zv, s_) do { zv = (f32x4){0.f, 0.f, 0.f, 0.f}; zv = mma16(kf[(s_) & 7][0], af[hg & 1][(s_) >> 3][0], zv); zv = mma16(kf[(s_) & 7][1], af[hg & 1][(s_) >> 3][1], zv); } while (0)
            SC_MMA(zc, 0);
#pragma unroll
            for (int s_i = 0; s_i < 16; ++s_i) {
                if (s_i < 15) SC_MMA(zn, s_i + 1);
                const float wq = wv[hg >> 1][2 * (hg & 1) + (s_i >> 3)]; const int st = s_i & 7;
                sc[st][0] += wq * relu1(zc[0]); sc[st][1] += wq * relu1(zc[1]); sc[st][2] += wq * relu1(zc[2]); sc[st][3] += wq * relu1(zc[3]);
                asm volatile("" : "+v"(sc[st]));
                zc = zn;
                __builtin_amdgcn_sched_barrier(0);
            }
#undef SC_MMA
            __builtin_amdgcn_sched_barrier(0);
        }
        if (more) {
            LAS unsigned char* kbn = kb + (par ^ 1) * 16384;
            *(LAS u32x4*)(kbn + (16 * w) * 128 + lane * 16) = kn0; *(LAS u32x4*)(kbn + (16 * w + 8) * 128 + lane * 16) = kn1;
            LDS_WAIT(); __builtin_amdgcn_s_barrier();
#pragma unroll
            for (int st = 0; st < 8; ++st) { kf[st][0] = *(LAS bf16x8*)(kbn + st * 2048 + o0); kf[st][1] = *(LAS bf16x8*)(kbn + st * 2048 + (o0 ^ 64)); }
        }
        float* sp = S + (size_t)(qt * 128 + 16 * w + fr) * T + kt * 128 + 4 * fq;
#pragma unroll
        for (int st = 0; st < 8; ++st) *(f32x4*)(sp + 16 * st) = sc[st];
        if (!more) break;
#pragma unroll
        for (int i = 0; i < 4; ++i) wv[i] = wn[i];
        par ^= 1; u = un; qt = qtn; kt = ktn; qa0 = qn0; qa1 = qn1;
    }
    VM_WAIT();
#undef SC_DMA
#undef SC_FRAG
}

__device__ __forceinline__ unsigned f2key(float v) { const unsigned u = __builtin_bit_cast(unsigned, v); return (u & 0x80000000u) ? ~u : (u | 0x80000000u); }
__device__ __forceinline__ unsigned wave_min_u32(unsigned v) {
#pragma unroll
    for (int o = 1; o < 64; o <<= 1) { const unsigned t = (unsigned)__shfl_xor((int)v, o); v = t < v ? t : v; }
    return v;
}
__device__ __forceinline__ unsigned wave_max_u32(unsigned v) {
#pragma unroll
    for (int o = 1; o < 64; o <<= 1) { const unsigned t = (unsigned)__shfl_xor((int)v, o); v = t > v ? t : v; }
    return v;
}
__device__ __forceinline__ void odd_topk(Frame& F, const int probe_stop = 0) {
    const float* S = WSP(float, WS_S); int* SEL = WSP(int, WS_SEL);
    constexpr int CCAP = 1920;
    LAS unsigned long long* cand = (LAS unsigned long long*)(F.lds + F.wave * 16384);
    LAS unsigned* bm = (LAS unsigned*)(F.lds + F.wave * 16384 + CCAP * 8);
    const int lane = F.lane; const unsigned long long lt = (1ull << lane) - 1ull;
    for (int t = F.gw; t < T; t += F.NGW) {
        const int n = t + 1; int* sel = SEL + (size_t)t * 256;
        if (n <= 256) { for (int i = lane; i < 256; i += 64) sel[i] = i < n ? i : 0; continue; }
        const float* row = S + (size_t)t * T; const int nch = (n + 63) >> 6; const int nit = (n + 1023) >> 10;
        unsigned a = 0u, b = 0u, c = 0u, d = 0u;
#define TK_INS(kk) do { const unsigned k_ = (kk); const unsigned t0 = k_ < a ? k_ : a; a = k_ < a ? a : k_; const unsigned t1 = t0 < b ? t0 : b; b = t0 < b ? b : t0; \
            const unsigned t2 = t1 < c ? t1 : c; c = t1 < c ? c : t1; d = t2 < d ? d : t2; } while (0)
#pragma unroll 1
        for (int it = 0; it < nit; ++it) {
            f32x4 v[4];
#pragma unroll
            for (int u = 0; u < 4; ++u) v[u] = *(const f32x4*)(row + it * 1024 + u * 256 + lane * 4);
#pragma unroll
            for (int u = 0; u < 4; ++u)
#pragma unroll
                for (int e = 0; e < 4; ++e) { const int s = it * 1024 + u * 256 + lane * 4 + e; TK_INS(s < n ? f2key(v[u][e]) : 0u); } }
#undef TK_INS
        const unsigned L = wave_min_u32(d);
        const unsigned kmax = wave_max_u32(a); const unsigned xd = L ^ kmax; const int sb = xd ? 31 - __builtin_clz(xd) : -1;
        const unsigned thr0 = sb < 0 ? L : (sb == 31 ? 0u : (L & ~((2u << sb) - 1u)));
        if (probe_stop == 1) { if (L == 0xFFFFFFFFu) sel[0] = 0; continue; }
        unsigned cnt = 0u;
#pragma unroll 1
        for (int it = 0; it < nit; ++it) {
            f32x4 v[4];
#pragma unroll
            for (int u = 0; u < 4; ++u) v[u] = *(const f32x4*)(row + it * 1024 + u * 256 + lane * 4);
#pragma unroll
            for (int u = 0; u < 4; ++u)
#pragma unroll
                for (int e = 0; e < 4; ++e) { const int s = it * 1024 + u * 256 + lane * 4 + e; const unsigned k = s < n ? f2key(v[u][e]) : 0u;
                    const bool pred = (s < n) && (k >= L); const unsigned long long mk = __ballot(pred);
                    if (pred) { const unsigned pos = cnt + (unsigned)__popcll(mk & lt); if (pos < (unsigned)CCAP) cand[pos] = ((unsigned long long)k << 32) | (unsigned)s; }
                    cnt += (unsigned)__popcll(mk); } }
        LDS_WAIT();
        if (probe_stop == 2) continue;
        unsigned thr = thr0;
        *(LAS u32x4*)(bm + 4 * lane) = (u32x4){0u, 0u, 0u, 0u};
        if (cnt <= (unsigned)CCAP) {
            const int ns = (int)((cnt + 63u) >> 6);
            if (cnt <= 512u) {
                unsigned ck[8];
#pragma unroll
                for (int jj = 0; jj < 8; ++jj) { const unsigned idx = jj * 64 + lane; ck[jj] = idx < cnt ? (unsigned)(cand[idx] >> 32) : 0u; }
#pragma unroll 1
                for (int bit = sb; bit >= 0; --bit) { const unsigned trial = thr | (1u << bit); unsigned c2 = 0u;
#pragma unroll
                    for (int jj = 0; jj < 8; ++jj) c2 += (unsigned)__popcll(__ballot(ck[jj] >= trial));
                    if (c2 >= 256u) thr = trial; }
            } else if (cnt <= 1024u) {
                unsigned ck[16];
#pragma unroll
                for (int jj = 0; jj < 16; ++jj) { const unsigned idx = jj * 64 + lane; ck[jj] = idx < cnt ? (unsigned)(cand[idx] >> 32) : 0u; }
#pragma unroll 1
                for (int bit = sb; bit >= 0; --bit) { const unsigned trial = thr | (1u << bit); unsigned c2 = 0u;
#pragma unroll
                    for (int jj = 0; jj < 16; ++jj) c2 += (unsigned)__popcll(__ballot(ck[jj] >= trial));
                    if (c2 >= 256u) thr = trial; }
            } else {
#pragma unroll 1
            for (int bit = sb; bit >= 0; --bit) { const unsigned trial = thr | (1u << bit); unsigned c2 = 0u;
                for (int jj = 0; jj < ns; ++jj) { const unsigned idx = jj * 64 + lane; const unsigned k = idx < cnt ? (unsigned)(cand[idx] >> 32) : 0u; c2 += (unsigned)__popcll(__ballot(k >= trial)); }
                if (c2 >= 256u) thr = trial; }
            }
            unsigned ngt = 0u;
            for (int jj = 0; jj < ns; ++jj) { const unsigned idx = jj * 64 + lane; const unsigned k = idx < cnt ? (unsigned)(cand[idx] >> 32) : 0u; ngt += (unsigned)__popcll(__ballot(k > thr)); }
            unsigned pg = 0u, pe = 0u;
            for (int jj = 0; jj < ns; ++jj) { const unsigned idx = jj * 64 + lane; const unsigned long long cv = idx < cnt ? cand[idx] : 0ull; const unsigned k = (unsigned)(cv >> 32);
                const bool gt = k > thr, eq = (idx < cnt) && (k == thr); const unsigned long long mg = __ballot(gt), me = __ballot(eq);
                const unsigned sidx = (unsigned)cv; bool take = gt;
                if (eq) { const unsigned e = pe + (unsigned)__popcll(me & lt); take = take || (ngt + e < 256u); }
                if (take) __hip_atomic_fetch_or(&bm[sidx >> 5], 1u << (sidx & 31u), __ATOMIC_RELAXED, __HIP_MEMORY_SCOPE_WORKGROUP);
                pg += (unsigned)__popcll(mg); pe += (unsigned)__popcll(me); }
        } else {
#pragma unroll 1
            for (int bit = sb; bit >= 0; --bit) { const unsigned trial = thr | (1u << bit); unsigned c2 = 0u;
                for (int ch = 0; ch < nch; ++ch) { const int s = ch * 64 + lane; const unsigned k = s < n ? f2key(row[s]) : 0u; c2 += (unsigned)__popcll(__ballot(k >= trial)); }
                if (c2 >= 256u) thr = trial; }
            unsigned ngt = 0u;
            for (int ch = 0; ch < nch; ++ch) { const int s = ch * 64 + lane; const unsigned k = s < n ? f2key(row[s]) : 0u; ngt += (unsigned)__popcll(__ballot(k > thr)); }
            unsigned pg = 0u, pe = 0u;
            for (int ch = 0; ch < nch; ++ch) { const int s = ch * 64 + lane; const unsigned k = s < n ? f2key(row[s]) : 0u;
                const bool gt = k > thr, eq = (s < n) && (k == thr); const unsigned long long mg = __ballot(gt), me = __ballot(eq);
                bool take = gt;
                if (eq) { const unsigned e = pe + (unsigned)__popcll(me & lt); take = take || (ngt + e < 256u); }
                if (take) __hip_atomic_fetch_or(&bm[(unsigned)s >> 5], 1u << ((unsigned)s & 31u), __ATOMIC_RELAXED, __HIP_MEMORY_SCOPE_WORKGROUP);
                pg += (unsigned)__popcll(mg); pe += (unsigned)__popcll(me); }
        }
        LDS_WAIT();
        { u32x4 wv = *(const LAS u32x4*)(bm + 4 * lane);
          const unsigned cl = (unsigned)(__popc(wv.x) + __popc(wv.y) + __popc(wv.z) + __popc(wv.w));
          unsigned inc = cl;
#pragma unroll
          for (int o = 1; o < 64; o <<= 1) { const unsigned tv = (unsigned)__shfl_up((int)inc, o); if (lane >= o) inc += tv; }
          unsigned pos = inc - cl;
#pragma unroll
          for (int jw = 0; jw < 4; ++jw) { unsigned wd = wv[jw]; while (wd) { const int bp = __ffs((int)wd) - 1; if (pos < 256u) sel[pos] = (4 * lane + jw) * 32 + bp; ++pos; wd &= wd - 1u; } } }
        LDS_WAIT();
    }
}

__device__ __forceinline__ void odd_attn(Frame& F, const int probe = 0) {
    const bf16* QL = WSP(bf16, WS_QL); const bf16* KV = WSP(bf16, WS_KV); const int* SEL = WSP(int, WS_SEL); bf16* OL = probe ? WSP(bf16, WS_S + 128 * MiB) : WSP(bf16, WS_OLAT);
    const int pmask = probe == 1 ? 255 : 0x7fffffff;
    constexpr int CHB = 16 * 1152;
    const int lane = F.lane, w = F.wave, qi = w >> 1, hw = w & 1, fr = lane & 15, fq = lane >> 4;
    LAS int* SLq = (LAS int*)(F.lds + 8 * CHB) + qi * 256;
    LAS unsigned char* XS = F.lds + 8 * CHB + 4096;
    int pk[9];
#pragma unroll
    for (int i = 0; i < 9; ++i) { const int p = 576 * hw + 64 * i + lane, row = p / 72, slot = p % 72; pk[i] = row * 128 + (slot ^ ((row >> 1) & 7)); }
    const int gA = (fr >> 1) & 7;
    const int trow = 4 * fq + (fr >> 2), gT = (trow >> 1) & 7;
    u32x2 selv = (u32x2){0u, 0u};
    if (F.cid < T / 4) selv = *(const u32x2*)(SEL + (size_t)(F.cid * 4 + qi) * 256 + hw * 128 + lane * 2);
    for (int grp = F.cid; grp < T / 4; grp += F.G) {
        const int t = grp * 4 + qi; const int nsel = (t + 1) < 256 ? (t + 1) : 256;
        const int nmax = (grp * 4 + 4) < 256 ? (grp * 4 + 4) : 256; const int nch = (nmax + 15) >> 4;
        __syncthreads();
        { const int i0 = hw * 128 + lane * 2; const int v0 = i0 < nsel ? (int)selv.x : 0, v1 = (i0 + 1) < nsel ? (int)selv.y : 0; SLq[i0] = v0 & pmask; SLq[i0 + 1] = v1 & pmask; }
        if (grp + F.G < T / 4) selv = *(const u32x2*)(SEL + (size_t)((grp + F.G) * 4 + qi) * 256 + hw * 128 + lane * 2);
#pragma unroll
        for (int i_ = 0; i_ < 9; ++i_) { const int row_ = pk[i_] >> 7, c16_ = pk[i_] & 127;
            __builtin_amdgcn_global_load_lds((const unsigned*)(QL + (size_t)t * QLD + row_ * 576 + c16_ * 8), (LAS unsigned*)(F.lds + (4 + qi) * CHB + 9216 * hw + 1024 * i_), 16, 0, 0); }
        __syncthreads();
#define AT_DMA(chn, bufn) do { _Pragma("unroll") for (int i_ = 0; i_ < 9; ++i_) { const int row_ = pk[i_] >> 7, c16_ = pk[i_] & 127; \
            __builtin_amdgcn_global_load_lds((const unsigned*)(KV + (size_t)SLq[16 * (chn) + row_] * 576 + c16_ * 8), (LAS unsigned*)(F.lds + ((bufn) * 4 + qi) * CHB + 9216 * hw + 1024 * i_), 16, 0, 0); } } while (0)
        AT_DMA(0, 0);
        VM_WAIT(); __syncthreads();
        bf16x8 qf[9];
        { const LAS unsigned char* qr = F.lds + (4 + qi) * CHB + fr * 1152;
#pragma unroll
          for (int j = 0; j < 9; ++j) qf[j] = *(const LAS bf16x8*)(qr + ((8 * j + 4 * hw + fq) ^ gA) * 16); }
        LDS_WAIT(); __syncthreads();
        f32x4 o[16];
#pragma unroll
        for (int q = 0; q < 16; ++q) o[q] = (f32x4){0.f, 0.f, 0.f, 0.f};
        float m_run = -INFINITY, l_run = 0.f;
#pragma unroll 1
        for (int ch = 0; ch < nch; ++ch) {
            const LAS unsigned char* cb = F.lds + ((ch & 1) * 4 + qi) * CHB;
            if (ch + 1 < nch && probe < 3) AT_DMA(ch + 1, (ch + 1) & 1);
            f32x4 s = (f32x4){0.f, 0.f, 0.f, 0.f}, s2 = s;
            const LAS unsigned char* ar = cb + fr * 1152; const int ca = 4 * hw + fq;
#pragma unroll
            for (int j = 0; j < 8; j += 2) { const bf16x8 a = *(const LAS bf16x8*)(ar + ((8 * j + ca) ^ gA) * 16), a2 = *(const LAS bf16x8*)(ar + ((8 * (j + 1) + ca) ^ gA) * 16);
                s = mma16(a, qf[j], s); s2 = mma16(a2, qf[j + 1], s2); }
            { const bf16x8 a = *(const LAS bf16x8*)(ar + ((64 + ca) ^ gA) * 16); s = mma16(a, qf[8], s); }
            s = s + s2;
            *(LAS f32x4*)(XS + (w * 64 + lane) * 16) = s;
            LDS_WAIT(); __syncthreads();
            s = s + *(const LAS f32x4*)(XS + ((w ^ 1) * 64 + lane) * 16);
            float cm = -INFINITY;
#pragma unroll
            for (int i = 0; i < 4; ++i) { s[i] = (16 * ch + 4 * fq + i) < nsel ? s[i] : -INFINITY; cm = fmaxf(cm, s[i]); }
            cm = fmaxf(cm, __shfl_xor(cm, 16)); cm = fmaxf(cm, __shfl_xor(cm, 32));
            const float m_new = fmaxf(m_run, cm);
            if (__any(m_new > m_run)) { const float al = exp2f(m_run - m_new);
#pragma unroll
                for (int q = 0; q < 16; ++q) o[q] = o[q] * al;
                l_run *= al; m_run = m_new; }
            const float p0 = exp2f(s[0] - m_run), p1 = exp2f(s[1] - m_run), p2 = exp2f(s[2] - m_run), p3 = exp2f(s[3] - m_run);
            l_run += (p0 + p1) + (p2 + p3);
            const u32x2 pb = (u32x2){pk2(p0, p1), pk2(p2, p3)}; const s16x4 bfr = __builtin_bit_cast(s16x4, pb);
            const LAS unsigned char* vr = cb + trow * 1152 + 8 * (fr & 1); const int c0 = (32 * hw + ((fr & 3) >> 1)) ^ gT;
#pragma unroll
            for (int q = 0; q < 16; ++q) { const s16x4 af = __builtin_bit_cast(s16x4, __builtin_amdgcn_ds_read_tr16_b64_v4i16((LAS s16x4*)(vr + ((c0 ^ (2 * q)) * 16))));
                o[q] = __builtin_amdgcn_mfma_f32_16x16x16bf16_1k(af, bfr, o[q], 0, 0, 0); if ((q & 3) == 3) __builtin_amdgcn_sched_barrier(0); }
            VM_WAIT(); LDS_WAIT(); __syncthreads();
        }
#undef AT_DMA
        float lt = l_run; lt += __shfl_xor(lt, 16); lt += __shfl_xor(lt, 32);
        const float inv = 1.f / lt;
        { LAS unsigned char* os = F.lds + qi * CHB + fr * 1056 + 512 * hw + 8 * fq;
#pragma unroll
          for (int q = 0; q < 16; ++q) { u32x2 ov; ov.x = pk2(o[q][0] * inv, o[q][1] * inv); ov.y = pk2(o[q][2] * inv, o[q][3] * inv); *(LAS u32x2*)(os + 32 * q) = ov; } }
        LDS_WAIT(); __syncthreads();
        { const LAS unsigned char* os = F.lds + qi * CHB + (8 * hw) * 1056 + lane * 16; bf16* op = OL + (size_t)t * 8192 + (8 * hw) * 512 + lane * 8;
#pragma unroll
          for (int hh = 0; hh < 8; ++hh) *(u32x4*)(op + hh * 512) = *(const LAS u32x4*)(os + hh * 1056); }
    }
    __syncthreads();
}

__device__ __forceinline__ void ln1_router(Frame& F, int layer, const bool do_route = true) {
    const bf16* H = WSP(bf16, WS_H); bf16* XB = WSP(bf16, WS_XB);
    const float* RT = WSP(float, WS_RT) + (size_t)layer * 36 * D;
    int* ROWTOK_ = WSP(int, WS_ROUTE); float* ROWGATE_ = WSP(float, WS_ROUTE + 1 * MiB); int* ASSIGN = WSP(int, WS_ROUTE + 2 * MiB);
    const float* g1 = FIN(17) + (size_t)layer * D; const float* b1 = FIN(18) + (size_t)layer * D;
    const float* gb = FIN(22) + layer * 4; const float* eb = FIN(24) + layer * 32;
    gu32* cnt = F_CTL + CW_CNT + layer * 32 * 64;
    const int lane = F.lane;
    constexpr int RB = 4;
    for (int m0 = F.gw * RB; m0 < T; m0 += F.NGW * RB) {
        f32x4 v[RB][8];
#pragma unroll
        for (int r = 0; r < RB; ++r) {
            const u32x4* hr = (const u32x4*)(H + (size_t)(m0 + r) * D) + lane; float s = 0.f;
#pragma unroll
            for (int j2 = 0; j2 < 4; ++j2) { const u32x4 hw4 = hr[64 * j2];
                v[r][2 * j2] = (f32x4){bflo(hw4.x), bfhi(hw4.x), bflo(hw4.y), bfhi(hw4.y)}; v[r][2 * j2 + 1] = (f32x4){bflo(hw4.z), bfhi(hw4.z), bflo(hw4.w), bfhi(hw4.w)};
                s += ((v[r][2 * j2][0] + v[r][2 * j2][1]) + (v[r][2 * j2][2] + v[r][2 * j2][3])) + ((v[r][2 * j2 + 1][0] + v[r][2 * j2 + 1][1]) + (v[r][2 * j2 + 1][2] + v[r][2 * j2 + 1][3])); }
            const float mean = wave_sum(s) * (1.f / D); float s2 = 0.f;
#pragma unroll
            for (int jj = 0; jj < 8; ++jj) { v[r][jj] = v[r][jj] - mean; s2 += (v[r][jj][0] * v[r][jj][0] + v[r][jj][1] * v[r][jj][1]) + (v[r][jj][2] * v[r][jj][2] + v[r][jj][3] * v[r][jj][3]); }
            const float rstd = rsqrtf(wave_sum(s2) * (1.f / D) + LN_EPS);
#pragma unroll
            for (int j2 = 0; j2 < 4; ++j2) { const int q4 = 2 * (lane + 64 * j2);
                const f32x4 gg0 = *((const f32x4*)g1 + q4), gg1 = *((const f32x4*)g1 + q4 + 1), bb0 = *((const f32x4*)b1 + q4), bb1 = *((const f32x4*)b1 + q4 + 1);
                v[r][2 * j2] = v[r][2 * j2] * rstd * gg0 + bb0; v[r][2 * j2 + 1] = v[r][2 * j2 + 1] * rstd * gg1 + bb1;
                u32x4 o; o.x = pk2(v[r][2 * j2][0], v[r][2 * j2][1]); o.y = pk2(v[r][2 * j2][2], v[r][2 * j2][3]); o.z = pk2(v[r][2 * j2 + 1][0], v[r][2 * j2 + 1][1]); o.w = pk2(v[r][2 * j2 + 1][2], v[r][2 * j2 + 1][3]);
                *((u32x4*)(XB + (size_t)(m0 + r) * D) + lane + 64 * j2) = o; }
        }
        float mylg[RB];
#pragma unroll
        for (int r = 0; r < RB; ++r) mylg[r] = 0.f;
#pragma unroll 1
        for (int e = 0; e < 36; ++e) { const f32x4* rr = (const f32x4*)(RT + (size_t)e * D) + 2 * lane; float p[RB];
#pragma unroll
            for (int r = 0; r < RB; ++r) p[r] = 0.f;
#pragma unroll
            for (int jj = 0; jj < 8; ++jj) { const f32x4 r4 = rr[128 * (jj >> 1) + (jj & 1)];
#pragma unroll
                for (int r = 0; r < RB; ++r) p[r] += (v[r][jj][0] * r4[0] + v[r][jj][1] * r4[1]) + (v[r][jj][2] * r4[2] + v[r][jj][3] * r4[3]); }
#pragma unroll
            for (int r = 0; r < RB; ++r) { const float q = wave_sum(p[r]); mylg[r] = (lane == e) ? q : mylg[r]; } }
        int e1r[RB], e2r[RB]; float ga1[RB], ga2[RB];
#pragma unroll
        for (int r = 0; r < RB; ++r) {
            float g0 = __shfl(mylg[r], 0) + gb[0], g1v = __shfl(mylg[r], 1) + gb[1], g2 = __shfl(mylg[r], 2) + gb[2], g3 = __shfl(mylg[r], 3) + gb[3];
            int gs = 0; float gm = g0;
            if (g1v > gm) { gm = g1v; gs = 1; } if (g2 > gm) { gm = g2; gs = 2; } if (g3 > gm) { gm = g3; gs = 3; }
            const float ggate = 1.f / (__expf(g0 - gm) + __expf(g1v - gm) + __expf(g2 - gm) + __expf(g3 - gm));
            float el[8];
#pragma unroll
            for (int k = 0; k < 8; ++k) el[k] = __shfl(mylg[r], 4 + gs * 8 + k) + eb[gs * 8 + k];
            int i1 = 0; float v1 = el[0];
#pragma unroll
            for (int k = 1; k < 8; ++k) if (el[k] > v1) { v1 = el[k]; i1 = k; }
            int i2 = -1; float v2 = -INFINITY;
#pragma unroll
            for (int k = 0; k < 8; ++k) if (k != i1 && el[k] > v2) { v2 = el[k]; i2 = k; }
            const float w1 = 1.f / (1.f + __expf(v2 - v1)), w2 = 1.f - w1;
            e1r[r] = gs * 8 + i1; e2r[r] = gs * 8 + i2; ga1[r] = w1 * ggate; ga2[r] = w2 * ggate;
        }
        if (do_route && lane < RB) {
            int e1 = e1r[0], e2 = e2r[0]; float q1 = ga1[0], q2 = ga2[0];
#pragma unroll
            for (int r = 1; r < RB; ++r) if (lane == r) { e1 = e1r[r]; e2 = e2r[r]; q1 = ga1[r]; q2 = ga2[r]; }
            const int m = m0 + lane;
            const unsigned p1 = __hip_atomic_fetch_add(cnt + e1 * 64, 1u, RLX_AGENT), p2 = __hip_atomic_fetch_add(cnt + e2 * 64, 1u, RLX_AGENT);
            ROWTOK_[e1 * CAP + p1] = m; ROWGATE_[e1 * CAP + p1] = q1; ROWTOK_[e2 * CAP + p2] = m; ROWGATE_[e2 * CAP + p2] = q2;
            ASSIGN[m * 2] = e1 * CAP + (int)p1; ASSIGN[m * 2 + 1] = e2 * CAP + (int)p2;
        }
    }
}
__device__ __forceinline__ void moe_tables(Frame& F, int layer) {
    LAS int* tab = (LAS int*)(F.lds + MOE_TAB_OFF);
    gu32* cnt = F_CTL + CW_CNT + layer * 32 * 64;
    __syncthreads();
    if (F.tid < 32) tab[40 + F.tid] = (int)__hip_atomic_load(cnt + F.tid * 64, RLX_AGENT);
    __syncthreads();
    if (F.tid == 0) { int a = 0; for (int e = 0; e < 32; ++e) { tab[e] = a; a += (tab[40 + e] + 255) >> 8; } tab[32] = a; }
    __syncthreads();
}
__device__ __forceinline__ void ln2_combine(Frame& F, int layer, const bool dummy_out = false) {
    const bf16* XBi = WSP(bf16, WS_XB); bf16* XB = dummy_out ? WSP(bf16, WS_U) : WSP(bf16, WS_XB); const bf16* YR = WSP(bf16, WS_YROWS); const int* ASSIGN = WSP(int, WS_ROUTE + 2 * MiB);
    const LAS int* tab = (const LAS int*)(F.lds + MOE_TAB_OFF);
    const float* g2 = FIN(19) + (size_t)layer * D; const float* b2 = FIN(20) + (size_t)layer * D;
    const int lane = F.lane;
    for (int m = F.gw; m < T; m += F.NGW) {
        const int a0 = ASSIGN[m * 2], a1 = ASSIGN[m * 2 + 1];
        const size_t r0 = (size_t)tab[a0 >> 13] * 256 + (a0 & (CAP - 1)), r1 = (size_t)tab[a1 >> 13] * 256 + (a1 & (CAP - 1));
        const u32x4* xr = (const u32x4*)(XBi + (size_t)m * D) + lane; const u32x4* y0 = (const u32x4*)(YR + r0 * D) + lane; const u32x4* y1 = (const u32x4*)(YR + r1 * D) + lane;
        f32x4 v[8]; float s = 0.f;
#pragma unroll
        for (int j2 = 0; j2 < 4; ++j2) { const u32x4 xv = xr[64 * j2]; const u32x4 p = y0[64 * j2], q = y1[64 * j2];
            v[2 * j2][0] = bflo(xv.x) * ALPHA + (bflo(p.x) + bflo(q.x)); v[2 * j2][1] = bfhi(xv.x) * ALPHA + (bfhi(p.x) + bfhi(q.x));
            v[2 * j2][2] = bflo(xv.y) * ALPHA + (bflo(p.y) + bflo(q.y)); v[2 * j2][3] = bfhi(xv.y) * ALPHA + (bfhi(p.y) + bfhi(q.y));
            v[2 * j2 + 1][0] = bflo(xv.z) * ALPHA + (bflo(p.z) + bflo(q.z)); v[2 * j2 + 1][1] = bfhi(xv.z) * ALPHA + (bfhi(p.z) + bfhi(q.z));
            v[2 * j2 + 1][2] = bflo(xv.w) * ALPHA + (bflo(p.w) + bflo(q.w)); v[2 * j2 + 1][3] = bfhi(xv.w) * ALPHA + (bfhi(p.w) + bfhi(q.w));
            s += ((v[2 * j2][0] + v[2 * j2][1]) + (v[2 * j2][2] + v[2 * j2][3])) + ((v[2 * j2 + 1][0] + v[2 * j2 + 1][1]) + (v[2 * j2 + 1][2] + v[2 * j2 + 1][3])); }
        const float mean = wave_sum(s) * (1.f / D); float s2 = 0.f;
#pragma unroll
        for (int jj = 0; jj < 8; ++jj) { v[jj] = v[jj] - mean; s2 += (v[jj][0] * v[jj][0] + v[jj][1] * v[jj][1]) + (v[jj][2] * v[jj][2] + v[jj][3] * v[jj][3]); }
        const float rstd = rsqrtf(wave_sum(s2) * (1.f / D) + LN_EPS);
#pragma unroll
        for (int j2 = 0; j2 < 4; ++j2) { const int q4 = 2 * (lane + 64 * j2);
            const f32x4 gg0 = *((const f32x4*)g2 + q4), gg1 = *((const f32x4*)g2 + q4 + 1), bb0 = *((const f32x4*)b2 + q4), bb1 = *((const f32x4*)b2 + q4 + 1);
            v[2 * j2] = v[2 * j2] * rstd * gg0 + bb0; v[2 * j2 + 1] = v[2 * j2 + 1] * rstd * gg1 + bb1;
            u32x4 o; o.x = pk2(v[2 * j2][0], v[2 * j2][1]); o.y = pk2(v[2 * j2][2], v[2 * j2][3]); o.z = pk2(v[2 * j2 + 1][0], v[2 * j2 + 1][1]); o.w = pk2(v[2 * j2 + 1][2], v[2 * j2 + 1][3]);
            *((u32x4*)(XB + (size_t)m * D) + lane + 64 * j2) = o; }
    }
}

#ifndef MK_SPLIT
#define MK_SPLIT 0
#endif
constexpr int NPHASE = 47;
struct Args { const float* in[31]; float* out; unsigned char* ws; int ph_lo, ph_hi; };

#define IN(k) (lo <= (k) && (k) < hi)
#define SEAM(k) do { if (!MK_SPLIT && (k) + 1 < hi) { XcdBarrier bar; bar.bar = (unsigned*)(F_CTL + CW_BAR); bar.x = xb_xcc_id(); bar.st = (volatile LAS unsigned*)(F.lds + MISC_OFF) + 8; xcd_barrier(bar); } } while (0)
#define tab ((LAS int*)(F.lds + MOE_TAB_OFF))
#define ROWTOK WSP(int, WS_ROUTE)
#define ROWGATE WSP(float, WS_ROUTE + 1 * MiB)
#ifndef PROBE_TOPK
#define PROBE_TOPK 0
#endif
#ifndef PROBE_MASK
#define PROBE_MASK 0u
#endif
#define PHASE(k, g, ...) if (IN(k)) { PHASE_BEGIN(); __VA_ARGS__; SEAM(k); } if ((g) >= 0 && ((PROBE_MASK >> ((g) & 31)) & 1u)) { if (IN(k)) { PHASE_BEGIN(); __VA_ARGS__; SEAM2(k); } }
#define PHASE2(k, g, FIRST, SECOND) if (IN(k)) { PHASE_BEGIN(); FIRST; SEAM(k); } if ((PROBE_MASK >> ((g) & 31)) & 1u) { if (IN(k)) { PHASE_BEGIN(); SECOND; SEAM2(k); } }
#define SEAM2(k) do { if (!MK_SPLIT) { XcdBarrier bar; bar.bar = (unsigned*)(F_CTL + CW_BAR); bar.x = xb_xcc_id(); bar.st = (volatile LAS unsigned*)(F.lds + MISC_OFF) + 8; xcd_barrier(bar); } } while (0)
__device__ __forceinline__ void ple_phase(Frame& F, int layer, float* Xout, bf16* XBout) {
    pg8::Gemm g{2048, 2048, 2048}; pg8::SchedDense S; S.init(32, 8, F.G, F.cid, WSP(bf16, WS_XB), (size_t)256 * 2048 * 2, WSP(bf16, WS_WPG) + (size_t)layer * 2048 * 2048, (size_t)256 * 2048 * 2);
    pg8::EpiPle E{WSP(bf16, WS_XB), Xout, XBout, WSP(bf16, WS_PP), FIN(30) + (size_t)layer * D};
    pg8::gemm_phase<pg8::EpiPle, pg8::SchedDense, true, false>(F.lds, g, S, E, F.tid);
}
template <int j> __device__ __forceinline__ void layer_pair(Frame& F, const int lo, const int hi) {
        const int b = 1 + 23 * j, o = b + 11, le = 2 * j, lod = 2 * j + 1;
        PHASE(b + 0, 1,
            pg8::Gemm g{2048, 2048, 2048}; pg8::SchedDense S; S.init(32, 26, F.G, F.cid, WSP(bf16, WS_XBN), (size_t)256 * 2048 * 2, WSP(bf16, WS_WIN_E) + (size_t)j * EV_INP * 2048, (size_t)256 * 2048 * 2);
            pg8::EpiBf16 E{WSP(bf16, WS_U), EV_INP, 1.f};
            pg8::gemm_phase<pg8::EpiBf16, pg8::SchedDense, true, false>(F.lds, g, S, E, F.tid);
            if (j == 0) moe_cvt_tail(F, 32 * 26, 0, 0, MOE_SEG0); else moe_cvt_tail(F, 32 * 26, 2, MOE_SEG0, MOE_SEG1);)
        PHASE(b + 2, 3,  even_states(F, j); even_swa(F, j);)
        PHASE(b + 3, 4,  even_scan(F);)
        PHASE(b + 4, 5,  even_y(F, j);)
        PHASE(b + 5, 6,
            pg8::Gemm g{3072, 3072, 3072}; pg8::SchedDense S; S.init(32, 8, F.G, F.cid, WSP(bf16, WS_YMIX), (size_t)256 * 3072 * 2, WSP(bf16, WS_WOUT_E) + (size_t)j * 2048 * 3072, (size_t)256 * 3072 * 2);
            pg8::EpiRes E{WSP(bf16, WS_XBN), WSP(bf16, WS_H)};
            pg8::gemm_phase<pg8::EpiRes, pg8::SchedDense, true, false>(F.lds, g, S, E, F.tid);)
        PHASE2(b + 6, 16, ln1_router(F, le), ln1_router(F, le, false))
        PHASE(b + 7, 7,
            moe_tables(F, le);
            pg8::Gemm g{2048, 2048, 2048}; pg8::SchedMoe<4, true> S; S.init(tab, F.G, F.cid, WSP(bf16, WS_XB), WSP(bf16, WS_WGU) + (size_t)le * 32 * 1024 * 2048, (size_t)1024 * 2048 * 2, (size_t)256 * 2048 * 2, ROWTOK);
            pg8::EpiGateUp E{WSP(bf16, WS_HID)};
            pg8::gemm_phase<pg8::EpiGateUp, pg8::SchedMoe<4, true>, true, true>(F.lds, g, S, E, F.tid);
            moe_cvt_tail(F, tab[32] * 4, lod, 0, MOE_SEG0);)
        PHASE(b + 8, 8,
            { pg8::Gemm g{512, 512, 512}; pg8::SchedMoe<8, false> S; S.init(tab, F.G, F.cid, WSP(bf16, WS_HID), WSP(bf16, WS_WD) + (size_t)le * 32 * 2048 * 512, (size_t)2048 * 512 * 2, (size_t)256 * 512 * 2, ROWTOK);
              pg8::EpiDown E{WSP(bf16, WS_YROWS), ROWGATE, tab};
              pg8::gemm_phase<pg8::EpiDown, pg8::SchedMoe<8, false>, true, false>(F.lds, g, S, E, F.tid); }
            { pg8::Gemm g{256, 256, 256}; pg8::SchedDense S; S.init(32, 8, F.G, F.cid, WSP(bf16, WS_PB) + (size_t)le * T * 256, (size_t)256 * 256 * 2, WSP(bf16, WS_WPP) + (size_t)le * 2048 * 256, (size_t)256 * 256 * 2);
              pg8::EpiBf16 E{WSP(bf16, WS_PP), D, 1.f};
              pg8::gemm_phase<pg8::EpiBf16, pg8::SchedDense, true, false>(F.lds, g, S, E, F.tid); })
        PHASE2(b + 9, 17, ln2_combine(F, le), ln2_combine(F, le, true))
        PHASE2(b + 10, 18, ple_phase(F, le, nullptr, WSP(bf16, WS_XBN)), ple_phase(F, le, nullptr, WSP(bf16, WS_U)))
        PHASE(o + 0, 9,
            pg8::Gemm g{2048, 2048, 2048}; pg8::SchedDense S; S.init(32, 19, F.G, F.cid, WSP(bf16, WS_XBN), (size_t)256 * 2048 * 2, WSP(bf16, WS_WIN_O) + (size_t)j * OD_INP * 2048, (size_t)256 * 2048 * 2);
            pg8::EpiBf16 E{WSP(bf16, WS_U), OD_INP, 1.f};
            pg8::gemm_phase<pg8::EpiBf16, pg8::SchedDense, true, false>(F.lds, g, S, E, F.tid);
            moe_cvt_tail(F, 32 * 19, lod, MOE_SEG0, MOE_SEG1);)
        PHASE(o + 1, 10,
            odd_prep(F, j);
            pg8::Gemm g{OD_INP, 128, 128}; pg8::SchedDense S; S.init(32, 32, F.G, F.cid, WSP(bf16, WS_U), (size_t)256 * OD_INP * 2, WSP(bf16, WS_WUK) + (size_t)j * 8192 * 128, (size_t)256 * 128 * 2);
            S.a_cdiv = 2; S.a_cstride = 192 * 2; S.n_div = 2; S.n_stride = 576;
            pg8::EpiBf16 E{WSP(bf16, WS_QL), QLD, MLA_QSCALE};
            pg8::gemm_phase<pg8::EpiBf16, pg8::SchedDense, true, false>(F.lds, g, S, E, F.tid);)
        PHASE(o + 2, 11,  odd_scores(F);)
        PHASE2(o + 3, 12, odd_topk(F), odd_topk(F, PROBE_TOPK))
        PHASE2(o + 4, 13, odd_attn(F), odd_attn(F, PROBE_TOPK))
        PHASE(o + 5, 14,
            pg8::Gemm g{8192, 1024, 1024}; pg8::SchedDense S; S.init(32, 8, F.G, F.cid, WSP(bf16, WS_OLAT), (size_t)256 * 8192 * 2, WSP(bf16, WS_WUV) + (size_t)j * 2048 * 1024, (size_t)256 * 1024 * 2);
            S.a_cdiv = 1; S.a_cstride = 1024 * 2;
            pg8::EpiBf16 E{WSP(bf16, WS_O), D, 1.f};
            pg8::gemm_phase<pg8::EpiBf16, pg8::SchedDense, true, false>(F.lds, g, S, E, F.tid);)
        PHASE(o + 6, 15,
            pg8::Gemm g{2048, 2048, 2048}; pg8::SchedDense S; S.init(32, 8, F.G, F.cid, WSP(bf16, WS_O), (size_t)256 * 2048 * 2, WSP(bf16, WS_WOUT_O) + (size_t)j * 2048 * 2048, (size_t)256 * 2048 * 2);
            pg8::EpiRes E{WSP(bf16, WS_XBN), WSP(bf16, WS_H)};
            pg8::gemm_phase<pg8::EpiRes, pg8::SchedDense, true, false>(F.lds, g, S, E, F.tid);)
        PHASE2(o + 7, 16, ln1_router(F, lod), ln1_router(F, lod, false))
        PHASE(o + 8, 7,
            moe_tables(F, lod);
            pg8::Gemm g{2048, 2048, 2048}; pg8::SchedMoe<4, true> S; S.init(tab, F.G, F.cid, WSP(bf16, WS_XB), WSP(bf16, WS_WGU) + (size_t)lod * 32 * 1024 * 2048, (size_t)1024 * 2048 * 2, (size_t)256 * 2048 * 2, ROWTOK);
            pg8::EpiGateUp E{WSP(bf16, WS_HID)};
            pg8::gemm_phase<pg8::EpiGateUp, pg8::SchedMoe<4, true>, true, true>(F.lds, g, S, E, F.tid);
            if (j == 0) moe_cvt_tail(F, tab[32] * 4, 2, 0, MOE_SEG0);)
        PHASE(o + 9, 8,
            { pg8::Gemm g{512, 512, 512}; pg8::SchedMoe<8, false> S; S.init(tab, F.G, F.cid, WSP(bf16, WS_HID), WSP(bf16, WS_WD) + (size_t)lod * 32 * 2048 * 512, (size_t)2048 * 512 * 2, (size_t)256 * 512 * 2, ROWTOK);
              pg8::EpiDown E{WSP(bf16, WS_YROWS), ROWGATE, tab};
              pg8::gemm_phase<pg8::EpiDown, pg8::SchedMoe<8, false>, true, false>(F.lds, g, S, E, F.tid); }
            { pg8::Gemm g{256, 256, 256}; pg8::SchedDense S; S.init(32, 8, F.G, F.cid, WSP(bf16, WS_PB) + (size_t)lod * T * 256, (size_t)256 * 256 * 2, WSP(bf16, WS_WPP) + (size_t)lod * 2048 * 256, (size_t)256 * 256 * 2);
              pg8::EpiBf16 E{WSP(bf16, WS_PP), D, 1.f};
              pg8::gemm_phase<pg8::EpiBf16, pg8::SchedDense, true, false>(F.lds, g, S, E, F.tid); })
        PHASE2(o + 10, 17, ln2_combine(F, lod), ln2_combine(F, lod, true))
        PHASE2(o + 11, 18, ple_phase(F, lod, j == 1 ? F_OUT : nullptr, WSP(bf16, WS_XBN)), ple_phase(F, lod, j == 1 ? WSP(float, WS_H) : nullptr, WSP(bf16, WS_U)))
    }
__global__ void __launch_bounds__(512, 2) fwd_kernel(Args args) {
    extern __shared__ __attribute__((aligned(16))) unsigned char lds_raw[];
    Frame F;
    F.lds = (LAS unsigned char*)lds_raw;
    F.tid = threadIdx.x; F.lane = F.tid & 63; F.wave = __builtin_amdgcn_readfirstlane(F.tid >> 6);
    F.G = gridDim.x; F.cid = blockIdx.x; F.gw = F.cid * 8 + F.wave; F.NGW = F.G * 8;
    F.ws = args.ws;
    F.ka = (const __attribute__((address_space(4))) unsigned char*)__builtin_amdgcn_kernarg_segment_ptr();
    for (int u = F.tid; u < (LDS_BYTES - LDSCTL_OFF) / 4; u += 512) ((LAS unsigned*)(F.lds + LDSCTL_OFF))[u] = 0u;
    __syncthreads();
    if (!MK_SPLIT) (void)xcd_barrier_post((unsigned*)(F_CTL + CW_BAR), (volatile LAS unsigned*)(F.lds + MISC_OFF) + 8);
    const int lo = args.ph_lo, hi = args.ph_hi;

    PHASE(0, 0, p0_prologue(F))
    layer_pair<0>(F, lo, hi);
    layer_pair<1>(F, lo, hi);
#undef IN
#undef SEAM
#undef tab
#undef ROWTOK
#undef ROWGATE
}

extern "C" void kernel_launch(void* const* d_in, const int* in_sizes, int n_in, void* d_out, int out_size, void* d_ws, size_t ws_size, hipStream_t stream) {
    static int grid = 0;
    if (grid == 0) {
        if (n_in != 31 || out_size != T * D || ws_size < WS_TOTAL) { fprintf(stderr, "kernel_launch: unexpected problem (n_in %d, out %d, ws %zu < %zu); nothing launched\n", n_in, out_size, ws_size, (size_t)WS_TOTAL); grid = -1; return; }
        int dev = 0, cus = 0, per_cu = 0;
        if (hipGetDevice(&dev) != hipSuccess || hipDeviceGetAttribute(&cus, hipDeviceAttributeMultiprocessorCount, dev) != hipSuccess) { grid = -1; return; }
        if (hipFuncSetAttribute((const void*)fwd_kernel, hipFuncAttributeMaxDynamicSharedMemorySize, LDS_BYTES) != hipSuccess) { fprintf(stderr, "kernel_launch: hipFuncSetAttribute failed\n"); grid = -1; return; }
        if (hipOccupancyMaxActiveBlocksPerMultiprocessor(&per_cu, (const void*)fwd_kernel, 512, LDS_BYTES) != hipSuccess || per_cu < 1) { fprintf(stderr, "kernel_launch: occupancy query reports %d blocks per CU\n", per_cu); }
        (void)hipGetLastError();
        grid = cus;
    }
    if (grid < 0) return;
    (void)hipMemsetAsync((char*)d_ws + WS_CTL, 0, CTL_ZERO_BYTES, stream);
    Args a{};
    for (int i = 0; i < 31; ++i) a.in[i] = (const float*)d_in[i];
    a.out = (float*)d_out; a.ws = (unsigned char*)d_ws;
#if MK_SPLIT
    for (int p = 0; p < NPHASE; ++p) { a.ph_lo = p; a.ph_hi = p + 1; hipLaunchKernelGGL(fwd_kernel, dim3(grid), dim3(512), LDS_BYTES, stream, a); }
#else
    a.ph_lo = 0; a.ph_hi = NPHASE;
    hipLaunchKernelGGL(fwd_kernel, dim3(grid), dim3(512), LDS_BYTES, stream, a);
#endif
    const hipError_t le = hipPeekAtLastError();
    if (le != hipSuccess) fprintf(stderr, "kernel_launch: launch failed: %s\n", hipGetErrorName(le));
}
```
